# Optimizing an MI355X kernel written in HIP

```python
import jax
import jax.numpy as jnp
from jax import lax
import numpy as np

D_MODEL = 1024
BATCH = 8
SEQ = 4096
DEPTH = 2

GRID_W = 64
CTX_LEN = 256
EPS = 1e-6
N_MOD = 6

A_HEADS = 8
A_KV_HEADS = 2
A_GROUP = A_HEADS // A_KV_HEADS
A_HEAD_DIM = 64
A_WIDTH = A_HEADS * A_HEAD_DIM
A_KV_WIDTH = A_KV_HEADS * A_HEAD_DIM
A_SCALE = A_HEAD_DIM ** -0.5
ROPE_THETA = 10000.0
ROPE_FREQS = A_HEAD_DIM // 4
Q_BLOCK = 128

B_GROUPS = 4
B_WIDTH = D_MODEL // 2
B_GROUP_DIM = B_WIDTH // B_GROUPS
POOL_WINDOWS = (2, 4, 8, 16)

EVEN_IN = A_WIDTH + 2 * A_KV_WIDTH + B_WIDTH
EVEN_OUT = A_WIDTH + B_WIDTH

C_HEADS = 16
C_HEAD_DIM = D_MODEL // C_HEADS
C_WIDTH = C_HEADS * C_HEAD_DIM
C_SCALE = C_HEAD_DIM ** -0.5
NA_ROWS_MAX = 8
NA_COLS = 16

N_GROUPS = 4
E_PER_GROUP = 8
N_EXPERTS = N_GROUPS * E_PER_GROUP
TOP_K = 2
D_EXPERT = D_MODEL // 2
MOE_BLOCK = 128

kernel_name = 'hybrid_gqa_pool_natten_hmoe_diffusion'


def rmsnorm(x, g):
    xf = x.astype(jnp.float32)
    y = xf * lax.rsqrt(jnp.mean(xf * xf, axis=-1, keepdims=True) + EPS)
    return (y * g.astype(jnp.float32)).astype(x.dtype)


def modulate(h, shift, scale):
    return h * (1 + scale) + shift


def axial_rope_tables(n_tok):
    t = jnp.arange(n_tok, dtype=jnp.int32)
    pos = jnp.stack([t // GRID_W, t % GRID_W], axis=-1).astype(jnp.float32)
    inv = ROPE_THETA ** (-jnp.arange(ROPE_FREQS, dtype=jnp.float32) / ROPE_FREQS)
    ang = pos[:, :, None] * inv
    return jnp.cos(ang), jnp.sin(ang)


def apply_axial_rope(x, cos, sin):
    sh = x.shape
    xr = x.reshape(sh[:-1] + (2, 2, ROPE_FREQS)).astype(jnp.float32)
    x1, x2 = xr[..., 0, :], xr[..., 1, :]
    out = jnp.stack([x1 * cos - x2 * sin, x1 * sin + x2 * cos], axis=-2)
    return out.reshape(sh).astype(x.dtype)


def gqa_queries(q, gain):
    B, L, _ = q.shape
    q = rmsnorm(q.reshape(B, L, A_KV_HEADS, A_GROUP, A_HEAD_DIM), gain)
    return q.transpose(0, 2, 3, 1, 4)


def gqa_keys(k, gain):
    B, L, _ = k.shape
    return rmsnorm(k.reshape(B, L, A_KV_HEADS, A_HEAD_DIM), gain).transpose(0, 2, 1, 3)


def gqa_values(v):
    B, L, _ = v.shape
    return v.reshape(B, L, A_KV_HEADS, A_HEAD_DIM).transpose(0, 2, 1, 3)


def pool_mixer(u, pool_w, pool_scale):
    B, L, _ = u.shape
    ug = u.reshape(B, L, B_GROUPS, B_GROUP_DIM).astype(jnp.float32)
    cs = jnp.concatenate([jnp.zeros((B, 1, B_GROUPS, B_GROUP_DIM), jnp.float32), jnp.cumsum(ug, axis=1)], axis=1)
    t = jnp.arange(L, dtype=jnp.int32)
    means = []
    for g, w in enumerate(POOL_WINDOWS):
        lo = jnp.clip(t - w // 2, 0, L)
        hi = jnp.clip(t - w // 2 + w, 0, L)
        cnt = (hi - lo).astype(jnp.float32)
        cs_g = cs[:, :, g]
        means.append((cs_g[:, hi] - cs_g[:, lo]) / cnt[None, :, None])
    pooled = (jnp.stack(means, axis=2) - ug).astype(u.dtype)
    mixed = jnp.einsum('blgc,gcd->blgd', pooled, pool_w)
    return mixed.reshape(B, L, B_WIDTH) * pool_scale


def even_mixer(h, hc, w_in, w_out, q_gain, k_gain, pool_w, pool_scale, cos, sin, ctx_out):
    B, S, _ = h.shape
    cuts = (A_WIDTH, A_WIDTH + A_KV_WIDTH, A_WIDTH + 2 * A_KV_WIDTH)
    q, k, v, u = jnp.split(h @ w_in, cuts, axis=-1)
    if ctx_out:
        qc, kc, vc, uc = jnp.split(hc @ w_in, cuts, axis=-1)
    else:
        kc, vc = jnp.split(hc @ w_in[:, A_WIDTH:A_WIDTH + 2 * A_KV_WIDTH], 2, axis=-1)
    kc_h = gqa_keys(kc, k_gain)
    vc_h = gqa_values(vc)
    q_h = apply_axial_rope(gqa_queries(q, q_gain), cos, sin)
    k_h = apply_axial_rope(gqa_keys(k, k_gain), cos, sin)
    k_all = jnp.concatenate([kc_h, k_h], axis=2)
    v_all = jnp.concatenate([vc_h, gqa_values(v)], axis=2)
    nb = S // Q_BLOCK
    qb = q_h.reshape(B, A_KV_HEADS, A_GROUP, nb, Q_BLOCK, A_HEAD_DIM).transpose(3, 0, 1, 2, 4, 5)

    def attend_block(qblk):
        s = jnp.einsum('bhgqd,bhkd->bhgqk', qblk, k_all).astype(jnp.float32) * A_SCALE
        p = jax.nn.softmax(s, axis=-1).astype(v_all.dtype)
        return jnp.einsum('bhgqk,bhkd->bhgqd', p, v_all)

    o = lax.map(attend_block, qb)
    a_lat = o.transpose(1, 0, 4, 2, 3, 5).reshape(B, S, A_WIDTH)
    b_lat = pool_mixer(u, pool_w, pool_scale)
    y = jnp.concatenate([a_lat, b_lat], axis=-1) @ w_out
    if not ctx_out:
        return y, None
    Lc = hc.shape[1]
    qc_h = gqa_queries(qc, q_gain)
    s = jnp.einsum('bhgqd,bhkd->bhgqk', qc_h, kc_h).astype(jnp.float32) * A_SCALE
    p = jax.nn.softmax(s, axis=-1).astype(vc_h.dtype)
    a_ctx = jnp.einsum('bhgqk,bhkd->bhgqd', p, vc_h).transpose(0, 3, 1, 2, 4).reshape(B, Lc, A_WIDTH)
    b_ctx = pool_mixer(uc, pool_w, pool_scale)
    yc = jnp.concatenate([a_ctx, b_ctx], axis=-1) @ w_out
    return y, yc


def c_heads(t):
    B, L, _ = t.shape
    return t.reshape(B, L, C_HEADS, C_HEAD_DIM).transpose(0, 2, 1, 3)


def odd_mixer(h, hc, w_in, w_out, rel_bias, ctx_out):
    B, S, _ = h.shape
    rows = S // GRID_W
    kh = min(NA_ROWS_MAX, rows)
    q, k, v = jnp.split(h @ w_in, 3, axis=-1)
    if ctx_out:
        qc, kc, vc = jnp.split(hc @ w_in, 3, axis=-1)
    else:
        kc, vc = jnp.split(hc @ w_in[:, C_WIDTH:], 2, axis=-1)
    kc_h, vc_h = c_heads(kc), c_heads(vc)

    def grid(t):
        return t.reshape(B, rows, GRID_W, C_HEADS, C_HEAD_DIM).transpose(0, 3, 1, 2, 4)

    qg, kg, vg = grid(q), grid(k), grid(v)
    cols = jnp.arange(GRID_W, dtype=jnp.int32)
    col_start = jnp.clip(cols - NA_COLS // 2, 0, GRID_W - NA_COLS)
    col_idx = col_start[:, None] + jnp.arange(NA_COLS, dtype=jnp.int32)[None, :]
    col_off = col_idx - cols[:, None] + (NA_COLS - 1)
    n_loc = kh * NA_COLS

    def row_block(r):
        rs = jnp.clip(r - kh // 2, 0, rows - kh)
        qr = lax.dynamic_index_in_dim(qg, r, axis=2, keepdims=False)
        kr = lax.dynamic_slice_in_dim(kg, rs, kh, axis=2)
        vr = lax.dynamic_slice_in_dim(vg, rs, kh, axis=2)
        kw = kr[:, :, :, col_idx]
        vw = vr[:, :, :, col_idx]
        row_off = rs + jnp.arange(kh, dtype=jnp.int32) - r + (NA_ROWS_MAX - 1)
        bias = rel_bias[:, row_off][:, :, col_off].transpose(0, 2, 1, 3)
        s_loc = jnp.einsum('bhqd,bhiqjd->bhqij', qr, kw).astype(jnp.float32) * C_SCALE + bias.astype(jnp.float32)
        s_ctx = jnp.einsum('bhqd,bhkd->bhqk', qr, kc_h).astype(jnp.float32) * C_SCALE
        s = jnp.concatenate([s_loc.reshape(B, C_HEADS, GRID_W, n_loc), s_ctx], axis=-1)
        p = jax.nn.softmax(s, axis=-1).astype(vw.dtype)
        p_loc = p[..., :n_loc].reshape(B, C_HEADS, GRID_W, kh, NA_COLS)
        return (jnp.einsum('bhqij,bhiqjd->bhqd', p_loc, vw)
                + jnp.einsum('bhqk,bhkd->bhqd', p[..., n_loc:], vc_h))

    o = lax.map(row_block, jnp.arange(rows, dtype=jnp.int32))
    y = o.transpose(1, 0, 3, 2, 4).reshape(B, S, C_WIDTH) @ w_out
    if not ctx_out:
        return y, None
    Lc = hc.shape[1]
    qc_h = c_heads(qc)
    s = jnp.einsum('bhqd,bhkd->bhqk', qc_h, kc_h).astype(jnp.float32) * C_SCALE
    p = jax.nn.softmax(s, axis=-1).astype(vc_h.dtype)
    yc = jnp.einsum('bhqk,bhkd->bhqd', p, vc_h).transpose(0, 2, 1, 3).reshape(B, Lc, C_WIDTH) @ w_out
    return y, yc


def hier_moe(xt, wg, bg, we, be, w1, w3, w2):
    T, D = xt.shape
    xf = xt.astype(jnp.float32)
    g_logits = xf @ wg.astype(jnp.float32) + bg.astype(jnp.float32)
    g_prob = jax.nn.softmax(g_logits, axis=-1)
    g_idx = jnp.argmax(g_logits, axis=-1)
    g_w = jnp.take_along_axis(g_prob, g_idx[:, None], axis=1)[:, 0]
    e_logits = (xf @ we.astype(jnp.float32) + be.astype(jnp.float32)).reshape(T, N_GROUPS, E_PER_GROUP)
    e_logits = jnp.take_along_axis(e_logits, g_idx[:, None, None], axis=1)[:, 0]
    top_p, top_e = lax.top_k(jax.nn.softmax(e_logits, axis=-1), TOP_K)
    top_p = top_p / jnp.sum(top_p, axis=-1, keepdims=True)
    weights = (g_w[:, None] * top_p).reshape(-1)
    flat_e = (g_idx[:, None] * E_PER_GROUP + top_e).reshape(-1)
    n_assign = T * TOP_K
    order = jnp.argsort(flat_e)
    sorted_e = flat_e[order]
    tok = order // TOP_K
    counts = jnp.bincount(flat_e, length=N_EXPERTS)
    start = jnp.cumsum(counts) - counts
    padded = (counts + MOE_BLOCK - 1) // MOE_BLOCK * MOE_BLOCK
    pend = jnp.cumsum(padded)
    pstart = pend - padded
    dest = pstart[sorted_e] + jnp.arange(n_assign, dtype=jnp.int32) - start[sorted_e]
    n_blocks = -(-n_assign // MOE_BLOCK) + N_EXPERTS
    xpad = jnp.zeros((n_blocks * MOE_BLOCK, D), xt.dtype).at[dest].set(xt[tok])
    block_e = jnp.minimum(jnp.searchsorted(pend, jnp.arange(n_blocks, dtype=jnp.int32) * MOE_BLOCK, side='right'), N_EXPERTS - 1)

    def expert_block(args):
        xb, e = args
        hb = jax.nn.silu(xb @ w1[e]) * (xb @ w3[e])
        return hb @ w2[e]

    ypad = lax.map(expert_block, (xpad.reshape(n_blocks, MOE_BLOCK, D), block_e))
    y = ypad.reshape(-1, D)[dest] * weights[order][:, None].astype(xt.dtype)
    return jnp.zeros_like(xt).at[tok].add(y)


def setup_inputs(seed: int = 0) -> dict:
    key = jax.random.key(seed)
    ks = iter(jax.random.split(key, 32))
    n_even = (DEPTH + 1) // 2
    n_odd = DEPTH // 2
    D = D_MODEL

    def nrm(shape, scale):
        return jax.random.normal(next(ks), shape, jnp.float32) * scale

    return {
        'x': nrm((BATCH, SEQ, D), 1.0),
        'c': nrm((BATCH, D), 1.0),
        'ctx': nrm((BATCH, CTX_LEN, D), 1.0),
        'c_ctx': nrm((D,), 1.0),
        'ada_w': nrm((DEPTH, D, N_MOD * D), 0.5 * D ** -0.5),
        'ada_b': nrm((DEPTH, N_MOD * D), 0.02),
        'norm_mix_g': 1.0 + nrm((DEPTH, D), 0.1),
        'norm_ffn_g': 1.0 + nrm((DEPTH, D), 0.1),
        'even_w_in': nrm((n_even, D, EVEN_IN), D ** -0.5),
        'even_w_out': nrm((n_even, EVEN_OUT, D), EVEN_OUT ** -0.5),
        'a_q_gain': 1.0 + nrm((n_even, A_HEAD_DIM), 0.1),
        'a_k_gain': 1.0 + nrm((n_even, A_HEAD_DIM), 0.1),
        'pool_w': nrm((n_even, B_GROUPS, B_GROUP_DIM, B_GROUP_DIM), B_GROUP_DIM ** -0.5),
        'pool_scale': 1.0 + nrm((n_even, B_WIDTH), 0.1),
        'odd_w_in': nrm((n_odd, D, 3 * C_WIDTH), D ** -0.5),
        'odd_w_out': nrm((n_odd, C_WIDTH, D), C_WIDTH ** -0.5),
        'na_rel_bias': nrm((n_odd, C_HEADS, 2 * NA_ROWS_MAX - 1, 2 * NA_COLS - 1), 0.5),
        'moe_w_group': nrm((DEPTH, D, N_GROUPS), D ** -0.5),
        'moe_b_group': nrm((DEPTH, N_GROUPS), 0.01),
        'moe_w_expert': nrm((DEPTH, D, N_EXPERTS), D ** -0.5),
        'moe_b_expert': nrm((DEPTH, N_EXPERTS), 0.01),
        'moe_w1': nrm((DEPTH, N_EXPERTS, D, D_EXPERT), D ** -0.5),
        'moe_w3': nrm((DEPTH, N_EXPERTS, D, D_EXPERT), D ** -0.5),
        'moe_w2': nrm((DEPTH, N_EXPERTS, D_EXPERT, D), D_EXPERT ** -0.5),
        'final_g': 1.0 + nrm((D,), 0.1),
    }


def reference(x, c, ctx, c_ctx, ada_w, ada_b, norm_mix_g, norm_ffn_g, even_w_in, even_w_out, a_q_gain, a_k_gain,
              pool_w, pool_scale, odd_w_in, odd_w_out, na_rel_bias, moe_w_group, moe_b_group, moe_w_expert,
              moe_b_expert, moe_w1, moe_w3, moe_w2, final_g):
    B, S, D = x.shape
    Lc = ctx.shape[1]
    cos, sin = axial_rope_tables(S)
    for l in range(DEPTH):
        last = l == DEPTH - 1
        mod = jax.nn.silu(c) @ ada_w[l] + ada_b[l]
        mod_c = jax.nn.silu(c_ctx) @ ada_w[l] + ada_b[l]
        sh1, sc1, g1, sh2, sc2, g2 = jnp.split(mod[:, None, :], N_MOD, axis=-1)
        csh1, csc1, cg1, csh2, csc2, cg2 = jnp.split(mod_c, N_MOD, axis=-1)
        h = modulate(rmsnorm(x, norm_mix_g[l]), sh1, sc1)
        hc = modulate(rmsnorm(ctx, norm_mix_g[l]), csh1, csc1)
        if l % 2 == 0:
            i = l // 2
            y, yc = even_mixer(h, hc, even_w_in[i], even_w_out[i], a_q_gain[i], a_k_gain[i], pool_w[i],
                               pool_scale[i], cos, sin, not last)
        else:
            i = l // 2
            y, yc = odd_mixer(h, hc, odd_w_in[i], odd_w_out[i], na_rel_bias[i], not last)
        x = x + g1 * y
        h2 = modulate(rmsnorm(x, norm_ffn_g[l]), sh2, sc2)
        moe_args = (moe_w_group[l], moe_b_group[l], moe_w_expert[l], moe_b_expert[l], moe_w1[l], moe_w3[l], moe_w2[l])
        if not last:
            ctx = ctx + cg1 * yc
            hc2 = modulate(rmsnorm(ctx, norm_ffn_g[l]), csh2, csc2)
            f = hier_moe(jnp.concatenate([h2.reshape(B * S, D), hc2.reshape(B * Lc, D)], axis=0), *moe_args)
            x = x + g2 * f[:B * S].reshape(B, S, D)
            ctx = ctx + cg2 * f[B * S:].reshape(B, Lc, D)
        else:
            f = hier_moe(h2.reshape(B * S, D), *moe_args)
            x = x + g2 * f.reshape(B, S, D)
    return rmsnorm(x, final_g)
```

```cpp
#include <hip/hip_runtime.h>
#include <hip/hip_cooperative_groups.h>
#include <hip/hip_bf16.h>
#include <cstdio>
#include <cstdint>
#include <cmath>
namespace cg = cooperative_groups;
namespace pg8 {
#define PG8_LAS __attribute__((address_space(3)))
typedef unsigned short bf16_t;
typedef short bf16x8 __attribute__((ext_vector_type(8)));
typedef float f32x4 __attribute__((ext_vector_type(4)));
typedef unsigned u32x4 __attribute__((ext_vector_type(4)));
constexpr int BM = 256, BK = 64, HALF = 128, HTB = HALF * BK * 2  , STAGE_BYTES = 8 * HTB, NXCD = 8, WGM = 8;

__host__ __device__ __forceinline__ int lds_byte(int r, int c) { const int st = (r >> 4) * 2 + (c >> 5), rr = r & 15, cc = c & 31, ob = rr * 64 + cc * 2; return st * 1024 + (ob ^ (((ob >> 9) & 1) << 5)); }
__host__ __device__ __forceinline__ void stage_rc(int b, int& R, int& C) { const int st = b / 1024, sb = b % 1024, swz = sb ^ (((sb >> 9) & 1) << 5); R = (st >> 1) * 16 + swz / 64; C = (st & 1) * 32 + (swz % 64) / 2; }
__host__ __device__ __forceinline__ int perm32(int rho) { const int n = rho >> 4, i = rho & 15; return 8 * (i >> 2) + 4 * n + (i & 3); }

struct Unit { int pm, pn; };
struct Gemm { const bf16_t* A; const bf16_t* Bt; int M, N, K; };

struct StaticOrder {
    int nM, nN, nwg, G, c;
    __host__ __device__ void init(int M, int N, int G_, int c_) { nM = M / BM; nN = N / BM; nwg = nM * nN; G = G_; c = c_; }
    __host__ __device__ bool next(int i, Unit& u) const {
        const long L = (long)i * G + c; if (L >= nwg) return false;
        int wgid = (int)L; { const int q = nwg / NXCD, r = nwg % NXCD, xcd = wgid % NXCD, off = wgid / NXCD; wgid = (xcd < r ? xcd * (q + 1) : r * (q + 1) + (xcd - r) * q) + off; }
        const int nig = WGM * nN, gid = wgid / nig, fm = gid * WGM, gsz = (nM - fm) < WGM ? (nM - fm) : WGM;
        u.pm = fm + ((wgid % nig) % gsz); u.pn = (wgid % nig) / gsz; return true;
    }
    __device__ __forceinline__ void a_ready(const Unit&) const {}
    __device__ __forceinline__ void done(const Unit&) const {}
};

__device__ __forceinline__ unsigned cvt_pk_bf16(float lo, float hi) { unsigned r; asm volatile("v_cvt_pk_bf16_f32 %0, %1, %2" : "=v"(r) : "v"(lo), "v"(hi)); return r; }
typedef float f32x2 __attribute__((ext_vector_type(2)));
struct DenseOrder {
    int nM, nN, nwg, G, c, mode, n2, pn2_0, nN2;
    __device__ __forceinline__ void init(int nM_, int nN_, int G_, int c_, int mode_, int n2_ = 0, int pn2_0_ = 0, int nN2_ = 1) { nM = nM_; nN = nN_; nwg = nM * nN; G = G_; c = c_; mode = mode_; n2 = n2_; pn2_0 = pn2_0_; nN2 = nN2_; }
    __device__ __forceinline__ bool next(int i, Unit& u) const {
        long L = (long)i * G + c;
        if (L < nwg) {
            int wgid = (int)L; { const int q = nwg / NXCD, r = nwg % NXCD, xcd = wgid % NXCD, off = wgid / NXCD; wgid = (xcd < r ? xcd * (q + 1) : r * (q + 1) + (xcd - r) * q) + off; }
            const int nig = WGM * nN, gid = wgid / nig, fm = gid * WGM, gsz = (nM - fm) < WGM ? (nM - fm) : WGM;
            int pm = fm + ((wgid % nig) % gsz); u.pn = (wgid % nig) / gsz;
            if (mode == 1) pm = pm + pm / 16 + 1;
            u.pm = pm; return true;
        }
        L -= nwg; if (L >= n2) return false;
        u.pm = 17 * (int)(L / nN2); u.pn = pn2_0 + (int)(L % nN2); return true;
    }
    __device__ __forceinline__ void a_ready(const Unit&) const {}
    __device__ __forceinline__ void done(const Unit&) const {}
};
struct MoeOrder {
    const PG8_LAS int* tstart; int nunits, G, c, ebase;
    __device__ __forceinline__ bool next(int i, Unit& u) const {
        const long L = (long)i * G + c; if (L >= nunits) return false;
        const int tile = (int)(L >> 2), j = (int)(L & 3); int e = 0;
#pragma unroll
        for (int k = 1; k < 32; ++k) e += (tile >= tstart[k]) ? 1 : 0;
        u.pm = tile; u.pn = (ebase + e) * 4 + j; return true;
    }
    __device__ __forceinline__ void a_ready(const Unit&) const {}
    __device__ __forceinline__ void done(const Unit&) const {}
};

struct EpiBf16 {
    static constexpr bool PERM = true, AFTER_DRAIN = false;
    bf16_t* O; int ldc; int split_cols; size_t split_stride; float scale0;
    __device__ __forceinline__ void operator()(const f32x4 (&acc)[2][2][4][2], const Unit& u, int wr, int wc, int fr, int fq) const {
        const int row0 = u.pm * BM + wr * 64 + fr; int colt = u.pn * BM; bf16_t* base = O;
        float sc = 1.f; if (split_cols) { const int t = colt / split_cols; base += (size_t)t * split_stride; colt -= t * split_cols; if (t == 0) sc = scale0; }
        const int col0 = colt + wc * 32 + 8 * fq;
#pragma unroll
        for (int ai = 0; ai < 2; ++ai)
#pragma unroll
            for (int m = 0; m < 4; ++m) { bf16_t* rowp = base + (size_t)(row0 + ai * HALF + m * 16) * ldc + col0;
#pragma unroll
                for (int bj = 0; bj < 2; ++bj) { f32x4 v0 = acc[ai][bj][m][0] * sc, v1 = acc[ai][bj][m][1] * sc;
                    u32x4 w; w.x = cvt_pk_bf16(v0[0], v0[1]); w.y = cvt_pk_bf16(v0[2], v0[3]); w.z = cvt_pk_bf16(v1[0], v1[1]); w.w = cvt_pk_bf16(v1[2], v1[3]);
                    *(u32x4*)(rowp + bj * HALF) = w; } }
    }
};
struct EpiEvenIn {
    static constexpr bool PERM = true, AFTER_DRAIN = false;
    bf16_t *Q, *K, *V, *U;
    __device__ __forceinline__ void operator()(const f32x4 (&acc)[2][2][4][2], const Unit& u, int wr, int wc, int fr, int fq) const {
        const int row0 = u.pm * BM + wr * 64 + fr, cw = wc * 32 + 8 * fq;
#pragma unroll
        for (int bj = 0; bj < 2; ++bj) {
            bf16_t* base; int ldc, col;
            if (u.pn < 2) { base = Q; ldc = 512; col = u.pn * 256 + bj * HALF + cw; }
            else if (u.pn == 2) { base = bj ? V : K; ldc = 128; col = cw; }
            else { base = U; ldc = 512; col = (u.pn - 3) * 256 + bj * HALF + cw; }
#pragma unroll
            for (int ai = 0; ai < 2; ++ai)
#pragma unroll
                for (int m = 0; m < 4; ++m) { const f32x4 v0 = acc[ai][bj][m][0], v1 = acc[ai][bj][m][1];
                    u32x4 w; w.x = cvt_pk_bf16(v0[0], v0[1]); w.y = cvt_pk_bf16(v0[2], v0[3]); w.z = cvt_pk_bf16(v1[0], v1[1]); w.w = cvt_pk_bf16(v1[2], v1[3]);
                    *(u32x4*)(base + (size_t)(row0 + ai * HALF + m * 16) * ldc + col) = w; }
        }
    }
};
struct EpiResid {
    static constexpr bool PERM = false, AFTER_DRAIN = false;
    const float* xin; const float* cin; float* xout; float* cout; const float* modg;
    __device__ __forceinline__ void operator()(const f32x4 (&acc)[2][2][4][2], const Unit& u, int wr, int wc, int fr, int fq) const {
        const int b = u.pm / 17, j = u.pm - b * 17;
        const float* src; float* dst; const float* g;
        if (j == 0) { src = cin + (size_t)b * 256 * 1024; dst = cout + (size_t)b * 256 * 1024; g = modg + 8 * 6144; }
        else { const size_t o = ((size_t)b * 4096 + (size_t)(j - 1) * 256) * 1024; src = xin + o; dst = xout + o; g = modg + b * 6144; }
        const int row0 = wr * 64 + fr, col0 = u.pn * BM + wc * 32 + 4 * fq;
        f32x4 gv[2][2];
#pragma unroll
        for (int bj = 0; bj < 2; ++bj)
#pragma unroll
            for (int n = 0; n < 2; ++n) gv[bj][n] = *(const f32x4*)(g + col0 + bj * HALF + n * 16);
#pragma unroll
        for (int ai = 0; ai < 2; ++ai)
#pragma unroll
            for (int m = 0; m < 4; ++m) { const size_t off = (size_t)(row0 + ai * HALF + m * 16) * 1024 + col0;
#pragma unroll
                for (int bj = 0; bj < 2; ++bj)
#pragma unroll
                    for (int n = 0; n < 2; ++n) { const f32x4 s = *(const f32x4*)(src + off + bj * HALF + n * 16); *(f32x4*)(dst + off + bj * HALF + n * 16) = s + gv[bj][n] * acc[ai][bj][m][n]; } }
    }
};
struct EpiMoeUp {
    static constexpr bool PERM = true, AFTER_DRAIN = false;
    bf16_t* H;
    __device__ __forceinline__ static float silu_mul(float a, float b) { return a * __builtin_amdgcn_rcpf(1.0f + __expf(-a)) * b; }
    __device__ __forceinline__ void operator()(const f32x4 (&acc)[2][2][4][2], const Unit& u, int wr, int wc, int fr, int fq) const {
        const int row0 = u.pm * BM + wr * 64 + fr, col = (u.pn & 3) * 128 + wc * 32 + 8 * fq;
#pragma unroll
        for (int ai = 0; ai < 2; ++ai)
#pragma unroll
            for (int m = 0; m < 4; ++m) { const f32x4 a0 = acc[ai][0][m][0], a1 = acc[ai][0][m][1], b0 = acc[ai][1][m][0], b1 = acc[ai][1][m][1];
                u32x4 w; w.x = cvt_pk_bf16(silu_mul(a0[0], b0[0]), silu_mul(a0[1], b0[1])); w.y = cvt_pk_bf16(silu_mul(a0[2], b0[2]), silu_mul(a0[3], b0[3]));
                w.z = cvt_pk_bf16(silu_mul(a1[0], b1[0]), silu_mul(a1[1], b1[1])); w.w = cvt_pk_bf16(silu_mul(a1[2], b1[2]), silu_mul(a1[3], b1[3]));
                *(u32x4*)(H + (size_t)(row0 + ai * HALF + m * 16) * 512 + col) = w; }
    }
};
struct EpiMoeDown {
    static constexpr bool PERM = true, AFTER_DRAIN = false;
    bf16_t* Y; const int* dstrow; const float* wgt;
    __device__ __forceinline__ void operator()(const f32x4 (&acc)[2][2][4][2], const Unit& u, int wr, int wc, int fr, int fq) const {
        const int slot0 = u.pm * BM + wr * 64 + fr, col = (u.pn & 3) * 256 + wc * 32 + 8 * fq;
#pragma unroll
        for (int ai = 0; ai < 2; ++ai)
#pragma unroll
            for (int m = 0; m < 4; ++m) { const int slot = slot0 + ai * HALF + m * 16; const int d = dstrow[slot]; const float wv = wgt[slot];
                if (d >= 0) {
#pragma unroll
                    for (int bj = 0; bj < 2; ++bj) { const f32x4 v0 = acc[ai][bj][m][0] * wv, v1 = acc[ai][bj][m][1] * wv;
                        u32x4 w; w.x = cvt_pk_bf16(v0[0], v0[1]); w.y = cvt_pk_bf16(v0[2], v0[3]); w.z = cvt_pk_bf16(v1[0], v1[1]); w.w = cvt_pk_bf16(v1[2], v1[3]);
                        *(u32x4*)(Y + (size_t)d * 1024 + col + bj * HALF) = w; } } }
    }
};

template <class Epi, class Sched, bool ALIGN_EPI = false, bool SP2 = false>
__device__ __forceinline__ void gemm_phase(PG8_LAS unsigned char* lds, const Gemm g, const Sched& S, const Epi& E) {
    const int tid = threadIdx.x, wid = __builtin_amdgcn_readfirstlane(tid >> 6), lane = tid & 63, wr = wid >> 2, wc = wid & 3, fr = lane & 15, fq = lane >> 4;
    const int K = g.K, nt = K / BK;
    unsigned voffA[2], voffB[2];
#pragma unroll
    for (int i = 0; i < 2; ++i) { int R, C; stage_rc(tid * 16 + i * 8192, R, C); const int Rb = Epi::PERM ? ((R & ~31) + perm32(R & 31)) : R;
        voffA[i] = (unsigned)(R * K + C) * 2u; voffB[i] = (unsigned)(Rb * K + C) * 2u; }
    const size_t kstep = (size_t)(BK * 2);
    const size_t hstep = (size_t)HALF * K * 2;
    const size_t tstep = 2 * hstep;
    const unsigned ldsw = (unsigned)wid * 1024u;
    const int aoff = lds_byte(wr * 64 + fr, fq * 8), boff = lds_byte(wc * 32 + fr, fq * 8);
#define PG8_SA(b, h) (((b) * 2 + (h)) * HTB)
#define PG8_SB(b, h) ((4 + (b) * 2 + (h)) * HTB)
#define PG8_STAGE(bufoff, gbase, voff) do { _Pragma("unroll") for (int _i = 0; _i < 2; ++_i) \
        __builtin_amdgcn_global_load_lds((const unsigned*)((const char*)(gbase) + (voff)[_i]), (PG8_LAS unsigned*)(lds + (bufoff) + ldsw + _i * 8192), 16, 0, 0); } while (0)
#define PG8_LDA(dst, b, h) do { _Pragma("unroll") for (int m = 0; m < 4; ++m) _Pragma("unroll") for (int k = 0; k < 2; ++k) dst[m][k] = *(const PG8_LAS bf16x8*)(lds + PG8_SA(b, h) + aoff + m * 2048 + k * 1024); } while (0)
#define PG8_LDB(dst, b, h) do { _Pragma("unroll") for (int n = 0; n < 2; ++n) _Pragma("unroll") for (int k = 0; k < 2; ++k) dst[n][k] = *(const PG8_LAS bf16x8*)(lds + PG8_SB(b, h) + boff + n * 2048 + k * 1024); } while (0)
#define PG8_MMA(ai, bj, At, Bt) do { __builtin_amdgcn_s_setprio(1); _Pragma("unroll") for (int m = 0; m < 4; ++m) _Pragma("unroll") for (int n = 0; n < 2; ++n) _Pragma("unroll") for (int k = 0; k < 2; ++k) \
        acc[ai][bj][m][n] = __builtin_amdgcn_mfma_f32_16x16x32_bf16(Bt[n][k], At[m][k], acc[ai][bj][m][n], 0, 0, 0); __builtin_amdgcn_s_setprio(0); } while (0)
#define PG8_WAIT_V(n) asm volatile("s_waitcnt vmcnt(" #n ")" ::: "memory")
#define PG8_WAIT_L(n) asm volatile("s_waitcnt lgkmcnt(" #n ")" ::: "memory")
#define PG8_BAR __builtin_amdgcn_s_barrier()
#define PG8_SCHED __builtin_amdgcn_sched_barrier(0)
    Unit cur, nxt; int ui = 0;
    if (!S.next(0, cur)) return;
    f32x4 acc[2][2][4][2];
#pragma unroll
    for (int a = 0; a < 2; ++a)
#pragma unroll
        for (int b = 0; b < 2; ++b)
#pragma unroll
            for (int m = 0; m < 4; ++m)
#pragma unroll
                for (int n = 0; n < 2; ++n) acc[a][b][m][n] = (f32x4){0.f, 0.f, 0.f, 0.f};
    bf16x8 At[4][2], B0[2][2], B1[2][2];
    const char* cA = (const char*)g.A + (size_t)cur.pm * tstep; const char* cB = (const char*)g.Bt + (size_t)cur.pn * tstep;
    S.a_ready(cur);
    if constexpr (SP2) {
        PG8_STAGE(PG8_SB(0, 0), cB, voffB); PG8_STAGE(PG8_SB(0, 1), cB + hstep, voffB); PG8_STAGE(PG8_SA(0, 0), cA, voffA); PG8_STAGE(PG8_SA(0, 1), cA + hstep, voffA);
        if (wr == 1) PG8_BAR;
        PG8_WAIT_V(2); PG8_BAR;
        PG8_STAGE(PG8_SB(1, 0), cB + kstep, voffB); PG8_STAGE(PG8_SA(1, 0), cA + kstep, voffA); PG8_STAGE(PG8_SB(1, 1), cB + hstep + kstep, voffB);
        PG8_WAIT_V(6); PG8_BAR;
    } else {
        PG8_STAGE(PG8_SB(0, 0), cB, voffB); PG8_STAGE(PG8_SA(0, 0), cA, voffA); PG8_STAGE(PG8_SB(0, 1), cB + hstep, voffB); PG8_STAGE(PG8_SA(0, 1), cA + hstep, voffA);
        if (wr == 1) PG8_BAR;
        PG8_WAIT_V(4); PG8_BAR;
        PG8_STAGE(PG8_SB(1, 0), cB + kstep, voffB); PG8_STAGE(PG8_SA(1, 0), cA + kstep, voffA); PG8_STAGE(PG8_SB(1, 1), cB + hstep + kstep, voffB);
        PG8_WAIT_V(6); PG8_BAR;
    }
    for (;;) {
        const bool has_next = S.next(ui + 1, nxt);
        const char* nA = has_next ? (const char*)g.A + (size_t)nxt.pm * tstep : cA; const char* nB = has_next ? (const char*)g.Bt + (size_t)nxt.pn * tstep : cB;
        for (int t = 0; t < nt; t += 2) {
            const bool last = (t == nt - 2);
            const char* a1 = cA + (size_t)(t + 1) * kstep;
            const char* a2 = last ? nA : cA + (size_t)(t + 2) * kstep; const char* b2 = last ? nB : cB + (size_t)(t + 2) * kstep;
            const char* a3 = a2 + kstep; const char* b3 = b2 + kstep;
            if (last && has_next) S.a_ready(nxt);
            if constexpr (SP2) {
            PG8_LDB(B0, 0, 0); PG8_LDB(B1, 0, 1); PG8_SCHED; PG8_LDA(At, 0, 0); PG8_STAGE(PG8_SA(1, 1), a1 + hstep, voffA);
            PG8_WAIT_V(8); PG8_WAIT_L(0); PG8_BAR; PG8_MMA(0, 0, At, B0); PG8_MMA(0, 1, At, B1); PG8_BAR; PG8_SCHED;
            PG8_LDA(At, 0, 1); PG8_STAGE(PG8_SB(0, 0), b2, voffB); PG8_STAGE(PG8_SB(0, 1), b2 + hstep, voffB); PG8_STAGE(PG8_SA(0, 0), a2, voffA);
            PG8_WAIT_V(8); PG8_WAIT_L(0); PG8_BAR; PG8_MMA(1, 0, At, B0); PG8_MMA(1, 1, At, B1); PG8_BAR; PG8_SCHED;
            PG8_LDB(B0, 1, 0); PG8_LDB(B1, 1, 1); PG8_SCHED; PG8_LDA(At, 1, 0); PG8_STAGE(PG8_SA(0, 1), a2 + hstep, voffA);
            PG8_WAIT_V(8); PG8_WAIT_L(0); PG8_BAR; PG8_MMA(0, 0, At, B0); PG8_MMA(0, 1, At, B1); PG8_BAR; PG8_SCHED;
            PG8_LDA(At, 1, 1); PG8_STAGE(PG8_SB(1, 0), b3, voffB); PG8_STAGE(PG8_SB(1, 1), b3 + hstep, voffB); PG8_STAGE(PG8_SA(1, 0), a3, voffA);
            PG8_WAIT_V(8); PG8_WAIT_L(0); PG8_BAR; PG8_MMA(1, 0, At, B0); PG8_MMA(1, 1, At, B1); PG8_BAR; PG8_SCHED;
            } else {
            PG8_LDB(B0, 0, 0); PG8_SCHED; PG8_LDA(At, 0, 0); PG8_STAGE(PG8_SA(1, 1), a1 + hstep, voffA);
            PG8_WAIT_L(8); PG8_BAR; PG8_WAIT_L(0); PG8_MMA(0, 0, At, B0); PG8_BAR; PG8_SCHED;
            PG8_LDB(B1, 0, 1); PG8_STAGE(PG8_SB(0, 0), b2, voffB);
            PG8_BAR; PG8_WAIT_L(0); PG8_MMA(0, 1, At, B1); PG8_BAR;
            PG8_LDA(At, 0, 1); PG8_STAGE(PG8_SA(0, 0), a2, voffA);
            PG8_BAR; PG8_WAIT_L(0); PG8_MMA(1, 0, At, B0); PG8_BAR; PG8_SCHED;
            PG8_STAGE(PG8_SB(0, 1), b2 + hstep, voffB);
            PG8_WAIT_V(6); PG8_BAR; PG8_MMA(1, 1, At, B1); PG8_BAR;
            PG8_LDB(B0, 1, 0); PG8_SCHED; PG8_LDA(At, 1, 0); PG8_STAGE(PG8_SA(0, 1), a2 + hstep, voffA);
            PG8_WAIT_L(8); PG8_BAR; PG8_WAIT_L(0); PG8_MMA(0, 0, At, B0); PG8_BAR; PG8_SCHED;
            PG8_LDB(B1, 1, 1); PG8_STAGE(PG8_SB(1, 0), b3, voffB);
            PG8_BAR; PG8_WAIT_L(0); PG8_MMA(0, 1, At, B1); PG8_BAR;
            PG8_LDA(At, 1, 1); PG8_STAGE(PG8_SA(1, 0), a3, voffA);
            PG8_BAR; PG8_WAIT_L(0); PG8_MMA(1, 0, At, B0); PG8_BAR; PG8_SCHED;
            PG8_STAGE(PG8_SB(1, 1), b3 + hstep, voffB);
            PG8_WAIT_V(6); PG8_BAR; PG8_MMA(1, 1, At, B1); PG8_BAR;
            }
        }
        if constexpr (ALIGN_EPI) { if (wr == 0) PG8_BAR; }
        if constexpr (!Epi::AFTER_DRAIN) { E(acc, cur, wr, wc, fr, fq); S.done(cur); }
        if (!has_next) break;
#pragma unroll
        for (int a = 0; a < 2; ++a)
#pragma unroll
            for (int b = 0; b < 2; ++b)
#pragma unroll
                for (int m = 0; m < 4; ++m)
#pragma unroll
                    for (int n = 0; n < 2; ++n) acc[a][b][m][n] = (f32x4){0.f, 0.f, 0.f, 0.f};
        cur = nxt; cA = nA; cB = nB; ++ui;
        if constexpr (ALIGN_EPI) { if (wr == 1) PG8_BAR; }
    }
    PG8_WAIT_V(0);
    if constexpr (!ALIGN_EPI) { if (wr == 0) PG8_BAR; }
    PG8_BAR;
    if constexpr (Epi::AFTER_DRAIN) { E.fused(acc, cur, wr, wc, fr, fq, lds, wid, lane); S.done(cur); }
#undef PG8_SA
#undef PG8_SB
#undef PG8_STAGE
#undef PG8_LDA
#undef PG8_LDB
#undef PG8_MMA
#undef PG8_WAIT_V
#undef PG8_WAIT_L
#undef PG8_BAR
#undef PG8_SCHED
}
}
namespace attn_body {
using bf16=__hip_bfloat16;
using bf16x8=__attribute__((ext_vector_type(8)))short;
using s16x4=__attribute__((ext_vector_type(4)))short;
using f32x16=__attribute__((ext_vector_type(16)))float;
using u32x4=__attribute__((ext_vector_type(4)))unsigned;
constexpr int D=64;
constexpr int NW=8,QBLK=32,QB=QBLK*NW,KVBLK=64;
__device__ __forceinline__ int crow(int r,int hi){return (r&3)+8*(r>>2)+4*hi;}
#define SBAR() __builtin_amdgcn_sched_barrier(0)
__device__ __forceinline__ void cmask(f32x16&p0,f32x16&p1,int jb,int qrel,int hi){
  const float NEG=-INFINITY; int kb=64*jb+4*hi;
  #pragma unroll
  for(int r=0;r<16;++r){int kv=kb+(r&3)+8*(r>>2); if(kv>qrel)p0[r]=NEG; if(kv+32>qrel)p1[r]=NEG;}
}

constexpr int NSLOT=3, SLOTB=8192;
constexpr int LDS_K=0, LDS_V=NSLOT*SLOTB, LDS_WS=2*NSLOT*SLOTB, LDS_OST=LDS_WS+NW*64*4, LDS_BYTES=LDS_OST+NW*4096;
constexpr float C2=0.125f*1.4426950408889634f;
__device__ __forceinline__ void glds16(const void*gsrc,unsigned lds_dst){unsigned keep;
  asm volatile("s_mov_b32 %0, m0\n\ts_mov_b32 m0, %2\n\ts_nop 0\n\tglobal_load_lds_dwordx4 %1, off\n\ts_mov_b32 m0, %0":"=&s"(keep):"v"(gsrc),"s"(lds_dst):"memory");}
__device__ __forceinline__ float max3f(float a,float b,float c){float r;asm("v_max3_f32 %0, %1, %2, %3":"=v"(r):"v"(a),"v"(b),"v"(c));return r;}
__device__ __forceinline__ float max2f(float a,float b){float r;asm("v_max_f32_e32 %0, %1, %2":"=v"(r):"v"(a),"v"(b));return r;}
__device__ __forceinline__ float fadd_s(float a,float b){float r;asm("v_add_f32_e32 %0, %1, %2":"=v"(r):"v"(a),"v"(b));return r;}
__device__ __forceinline__ float fsub_s(float a,float b){float r;asm("v_sub_f32_e32 %0, %1, %2":"=v"(r):"v"(a),"v"(b));return r;}
typedef float f32x2_t __attribute__((ext_vector_type(2))); typedef __bf16 bf16x2_t __attribute__((ext_vector_type(2)));
__device__ __forceinline__ unsigned cvtpk_s(float lo,float hi){f32x2_t v={lo,hi};bf16x2_t b=__builtin_convertvector(v,bf16x2_t);return __builtin_bit_cast(unsigned,b);}
#define WAIT_BAR(N) asm volatile("s_waitcnt vmcnt(" #N ") lgkmcnt(0)\n\ts_barrier":::"memory")

__device__ __forceinline__ void qkt(f32x16&p0,f32x16&p1,const char*Kslot,const bf16x8*qr,const f32x16&negm,int r32,int hi){
  const char*kb=Kslot+hi*1024+r32*16;
  #pragma unroll
  for(int d0=0;d0<4;++d0){
    const bf16x8 b0=*reinterpret_cast<const bf16x8*>(kb+d0*2048);
    const bf16x8 b1=*reinterpret_cast<const bf16x8*>(kb+d0*2048+512);
    if(d0==0){p0=__builtin_amdgcn_mfma_f32_32x32x16_bf16(b0,qr[0],negm,0,0,0);p1=__builtin_amdgcn_mfma_f32_32x32x16_bf16(b1,qr[0],negm,0,0,0);}
    else{p0=__builtin_amdgcn_mfma_f32_32x32x16_bf16(b0,qr[d0],p0,0,0,0);p1=__builtin_amdgcn_mfma_f32_32x32x16_bf16(b1,qr[d0],p1,0,0,0);}}
}
typedef __attribute__((address_space(3))) const char* lds_cptr;
typedef short v4i16_t __attribute__((ext_vector_type(4)));
__device__ __forceinline__ void kload8(bf16x8*kf,lds_cptr kp){
  kf[0]=*(const __attribute__((address_space(3))) bf16x8*)(kp);      kf[1]=*(const __attribute__((address_space(3))) bf16x8*)(kp+512);
  kf[2]=*(const __attribute__((address_space(3))) bf16x8*)(kp+2048); kf[3]=*(const __attribute__((address_space(3))) bf16x8*)(kp+2560);
  kf[4]=*(const __attribute__((address_space(3))) bf16x8*)(kp+4096); kf[5]=*(const __attribute__((address_space(3))) bf16x8*)(kp+4608);
  kf[6]=*(const __attribute__((address_space(3))) bf16x8*)(kp+6144); kf[7]=*(const __attribute__((address_space(3))) bf16x8*)(kp+6656);
}
__device__ __forceinline__ void kload2(bf16x8*kf,lds_cptr kp,int j){ kf[2*j]=*(const __attribute__((address_space(3))) bf16x8*)(kp+j*2048); kf[2*j+1]=*(const __attribute__((address_space(3))) bf16x8*)(kp+j*2048+512); }
__device__ __forceinline__ s16x4 vtr(lds_cptr p){ return __builtin_bit_cast(s16x4,__builtin_amdgcn_ds_read_tr16_b64_v4i16((__attribute__((address_space(3))) v4i16_t*)p)); }
__device__ __forceinline__ float rowmax(const f32x16&p0,const f32x16&p1){
  float a=max3f(p0[0],p0[1],p1[0]),b=max3f(p0[2],p0[3],p1[1]);a=max3f(a,p1[2],p1[3]);
  #pragma unroll
  for(int r=4;r<16;r+=4){a=max3f(a,p0[r],p0[r+1]);b=max3f(b,p0[r+2],p0[r+3]);a=max3f(a,p1[r],p1[r+1]);b=max3f(b,p1[r+2],p1[r+3]);}
  const float m=max2f(a,b);
  auto rr=__builtin_amdgcn_permlane32_swap(__float_as_uint(m),__float_as_uint(m),false,false);
  return max2f(__uint_as_float(rr[0]),__uint_as_float(rr[1]));
}
__device__ __forceinline__ void pv(f32x16*o,int vb,bf16x8 pa0,bf16x8 pa1,bf16x8 pa2,bf16x8 pa3){
  #pragma unroll
  for(int d0=0;d0<2;++d0){s16x4 lo[4],hi[4];
    #pragma unroll
    for(int ks=0;ks<4;++ks){
      asm volatile("ds_read_b64_tr_b16 %0,%1 offset:%c2":"=&v"(lo[ks]):"v"(vb),"i"(d0*4096+ks*1024):"memory");
      asm volatile("ds_read_b64_tr_b16 %0,%1 offset:%c2":"=&v"(hi[ks]):"v"(vb),"i"(d0*4096+ks*1024+512):"memory");}
    asm volatile("s_waitcnt lgkmcnt(0)":::"memory");SBAR();
    #define PK(k) (bf16x8){lo[k][0],lo[k][1],lo[k][2],lo[k][3],hi[k][0],hi[k][1],hi[k][2],hi[k][3]}
    o[d0]=__builtin_amdgcn_mfma_f32_32x32x16_bf16(pa0,PK(0),o[d0],0,0,0);
    o[d0]=__builtin_amdgcn_mfma_f32_32x32x16_bf16(pa1,PK(1),o[d0],0,0,0);
    o[d0]=__builtin_amdgcn_mfma_f32_32x32x16_bf16(pa2,PK(2),o[d0],0,0,0);
    o[d0]=__builtin_amdgcn_mfma_f32_32x32x16_bf16(pa3,PK(3),o[d0],0,0,0);
    #undef PK
  }
}

#ifndef ATTN_STORE16
#define ATTN_STORE16(p,v) (*(u32x4*)(p)=(v))
#endif
template<int THRL,int QP,int KP,int VP,int OP,class Hook> __device__ __forceinline__ void attn_unit(const bf16*Qw0,const bf16*__restrict__ Kh,const bf16*__restrict__ Vh,bf16*Ow0,const int NT,const Hook&hk,char*shm){
  const int tid=threadIdx.x,lane=tid&63,r32=lane&31,hi=lane>>5; const int wid=__builtin_amdgcn_readfirstlane(tid>>6);
  const bf16*Qw=Qw0+(long)(wid*QBLK)*QP;
  const unsigned lds0=(unsigned)(uintptr_t)shm;
  float*wsf=(float*)(shm+LDS_WS)+wid*64;
  const bf16*ksrc=Kh+(long)lane*KP+wid*8;
  const bf16*vsrc=Vh+(long)(16*(wid&3)+(lane>>2))*VP+(wid>>2)*32+(lane&3)*8;
  const unsigned kdst=lds0+LDS_K+wid*1024, vdst=lds0+LDS_V+wid*1024;
  #define DMA_K(t,slot) glds16(ksrc+(long)hk.tile_row(t)*KP,(unsigned)__builtin_amdgcn_readfirstlane(kdst+(slot)))
  #define DMA_V(t,slot) glds16(vsrc+(long)hk.tile_row(t)*VP,(unsigned)__builtin_amdgcn_readfirstlane(vdst+(slot)))
  const int vb0=(int)(lds0+LDS_V)+((lane>>4)&1)*32+(lane&3)*8+(4*hi+((lane&15)>>2))*64;
  const char*Kbase=shm+LDS_K; bf16x8 kf[8];
  const lds_cptr shm3=(lds_cptr)shm; const lds_cptr kp0=shm3+LDS_K+hi*1024+r32*16; const lds_cptr vp0=shm3+LDS_V+((lane>>4)&1)*32+(lane&3)*8+(4*hi+((lane&15)>>2))*64;
  DMA_K(0,0);DMA_V(0,0);DMA_K(1,SLOTB);
  bf16x8 qr[4];
  #pragma unroll
  for(int d0=0;d0<4;++d0)qr[d0]=*reinterpret_cast<const bf16x8*>(&Qw[(long)r32*QP+d0*16+hi*8]);
  float mhat=0.f,l_reg=0.f;f32x16 o[2];o[0]=f32x16{};o[1]=f32x16{};f32x16 negm=f32x16{};if(Hook::NEGC)asm volatile("":"+v"(negm)); const f32x16 zc=f32x16{};
  #define CMASK(P0,P1,t) do{ if(Hook::MASK) hk.mask(P0,P1,(t),mhat); }while(0)
  bool resc=false;
  #define START(P0,P1) do{ const float rm=rowmax(P0,P1); resc=false; \
    { const float dl=rm; mhat=fadd_s(mhat,dl); \
      _Pragma("unroll") for(int r=0;r<16;++r){P0[r]=fsub_s(P0[r],dl);P1[r]=fsub_s(P1[r],dl);} \
      if(Hook::NEGC){ _Pragma("unroll") for(int r=0;r<16;++r)negm[r]=-mhat; asm volatile("":"+v"(negm)); } } \
    _Pragma("unroll") for(int r=0;r<16;++r)P0[r]=__builtin_amdgcn_exp2f(P0[r]); }while(0)
  #define RESC() do{ if(resc){ asm volatile("s_waitcnt lgkmcnt(0)":::"memory"); \
      _Pragma("unroll") for(int d_=0;d_<2;++d_) _Pragma("unroll") for(int r=0;r<16;++r)o[d_][r]*=wsf[crow(r,hi)]; } }while(0)
  f32x16 pA0,pA1,pB0,pB1;
  int sl_prev=0,sl_cur=0,sl_next=SLOTB;
  #define ROT() do{sl_prev=sl_cur;sl_cur=sl_next;sl_next=(sl_next==(NSLOT-1)*SLOTB)?0:sl_next+SLOTB;}while(0)
  DMA_K(2,2*SLOTB);
  WAIT_BAR(3);
  qkt(pA0,pA1,Kbase,qr,(Hook::NEGC?negm:zc),r32,hi);asm volatile("s_nop 15\n\ts_nop 7":"+v"(pA0),"+v"(pA1));CMASK(pA0,pA1,0);
  START(pA0,pA1);
  _Pragma("unroll") for(int r=0;r<16;++r)pA1[r]=__builtin_amdgcn_exp2f(pA1[r]);
  WAIT_BAR(0);
  DMA_K(3,0);DMA_V(1,SLOTB);
  ROT();
  kload8(kf,kp0+sl_cur);
  WAIT_BAR(2);
  s16x4 vlo[8],vhi[8]; u32x4 pw0,pw1,pw2,pw3;
  #define PKW(P,B) cvtpk_s(P[B],P[B+1])
  #define PAF(k) __builtin_bit_cast(bf16x8,pw##k)
  #define VFR(i) (bf16x8){vlo[i][0],vlo[i][1],vlo[i][2],vlo[i][3],vhi[i][0],vhi[i][1],vhi[i][2],vhi[i][3]}
  #define PIN(x) asm volatile("":"+v"(x))
  #define MX3(a,b,c) __builtin_fmaxf(__builtin_fmaxf((a),(b)),(c))
  #define GAPA(MF,A0,A1,A2,A3,W0,W1,PW) do{ MF; sacc+=A0; sacc+=A1; sacc+=A2; sacc+=A3; PIN(sacc); W0; W1; PIN(PW); SBAR(); }while(0)
  #define EX(v) __builtin_amdgcn_exp2f(v)
  #define GAPB(MF,X,B) do{ MF; X[B]=EX(X[B]); X[B+1]=EX(X[B+1]); X[B+2]=EX(X[B+2]); X[B+3]=EX(X[B+3]); PIN(X); SBAR(); }while(0)
  #define VRD(i) do{ vlo[i]=vtr(vp_+(((i)>>2)*4096+((i)&3)*1024)); vhi[i]=vtr(vp_+(((i)>>2)*4096+((i)&3)*1024+512)); }while(0)
  #define KRD(G,j) do{ if(G){ kload2(kf,kp0+sl_next,j); SBAR(); } }while(0)
  #define STEP(C0,C1,P0,P1,t,GK,GV,GL) do{ SBAR(); \
    const lds_cptr vp_=vp0+sl_prev; \
    VRD(0); SBAR(); float sacc=(P0[0]+P0[1]); \
    GAPA(C0=__builtin_amdgcn_mfma_f32_32x32x16_bf16(kf[0],qr[0],(Hook::NEGC?negm:zc),0,0,0), P0[2],P0[3],P0[4],P0[5],     pw0[0]=PKW(P0,0), pw0[1]=PKW(P0,2), pw0); \
    VRD(4); SBAR(); GAPA(C1=__builtin_amdgcn_mfma_f32_32x32x16_bf16(kf[1],qr[0],(Hook::NEGC?negm:zc),0,0,0), P0[6],P0[7],P0[8],P0[9],     pw0[2]=PKW(P0,4), pw0[3]=PKW(P0,6), pw0); \
    VRD(1); SBAR(); GAPA(C0=__builtin_amdgcn_mfma_f32_32x32x16_bf16(kf[2],qr[1],C0,0,0,0),   P0[10],P0[11],P0[12],P0[13], pw1[0]=PKW(P0,8), pw1[1]=PKW(P0,10), pw1); \
    VRD(5); SBAR(); GAPA(C1=__builtin_amdgcn_mfma_f32_32x32x16_bf16(kf[3],qr[1],C1,0,0,0),   P0[14],P0[15],P1[0],P1[1],   pw1[2]=PKW(P0,12),pw1[3]=PKW(P0,14), pw1); \
    VRD(2); SBAR(); GAPA(C0=__builtin_amdgcn_mfma_f32_32x32x16_bf16(kf[4],qr[2],C0,0,0,0),   P1[2],P1[3],P1[4],P1[5],     pw2[0]=PKW(P1,0), pw2[1]=PKW(P1,2), pw2); \
    VRD(6); SBAR(); GAPA(C1=__builtin_amdgcn_mfma_f32_32x32x16_bf16(kf[5],qr[2],C1,0,0,0),   P1[6],P1[7],P1[8],P1[9],     pw2[2]=PKW(P1,4), pw2[3]=PKW(P1,6), pw2); \
    VRD(3); SBAR(); GAPA(C0=__builtin_amdgcn_mfma_f32_32x32x16_bf16(kf[6],qr[3],C0,0,0,0),   P1[10],P1[11],P1[12],P1[13], pw3[0]=PKW(P1,8), pw3[1]=PKW(P1,10), pw3); \
    VRD(7); SBAR(); GAPA(C1=__builtin_amdgcn_mfma_f32_32x32x16_bf16(kf[7],qr[3],C1,0,0,0),   P1[14],P1[15],0.f,0.f,       pw3[2]=PKW(P1,12),pw3[3]=PKW(P1,14), pw3); \
    l_reg+=sacc; \
    if(GK){DMA_K((t)+3,sl_cur);} if(GV){DMA_V((t)+1,sl_next);} \
    CMASK(C0,C1,t); \
    { float a=MX3(C0[0],C0[1],C1[0]),b=MX3(C0[2],C0[3],C1[1]); a=MX3(a,C1[2],C1[3]); \
      _Pragma("unroll") for(int r=4;r<16;r+=4){a=MX3(a,C0[r],C0[r+1]);b=MX3(b,C0[r+2],C0[r+3]);a=MX3(a,C1[r],C1[r+1]);b=MX3(b,C1[r+2],C1[r+3]);} \
      float rm=__builtin_fmaxf(a,b); { auto rr=__builtin_amdgcn_permlane32_swap(__float_as_uint(rm),__float_as_uint(rm),false,false); rm=__builtin_fmaxf(__uint_as_float(rr[0]),__uint_as_float(rr[1])); } \
      resc=false; \
      if(__builtin_expect(__any(rm>(float)THRL),0)){ const float dl=__builtin_fmaxf(rm,0.f); mhat+=dl; \
        _Pragma("unroll") for(int r=0;r<16;++r){C0[r]-=dl;C1[r]-=dl;} \
        if(Hook::NEGC){ _Pragma("unroll") for(int r=0;r<16;++r)negm[r]=-mhat; asm volatile("":"+v"(negm)); } \
        const float f=__builtin_amdgcn_exp2f(-dl); l_reg*=f; if(hi==0)wsf[r32]=f; resc=true; } } \
    SBAR(); \
    GAPB(o[0]=__builtin_amdgcn_mfma_f32_32x32x16_bf16(PAF(0),VFR(0),o[0],0,0,0), C0,0); \
    GAPB(o[1]=__builtin_amdgcn_mfma_f32_32x32x16_bf16(PAF(0),VFR(4),o[1],0,0,0), C0,4); \
    KRD(GL,0); GAPB(o[0]=__builtin_amdgcn_mfma_f32_32x32x16_bf16(PAF(1),VFR(1),o[0],0,0,0), C0,8); \
    KRD(GL,1); GAPB(o[1]=__builtin_amdgcn_mfma_f32_32x32x16_bf16(PAF(1),VFR(5),o[1],0,0,0), C0,12); \
    KRD(GL,2); GAPB(o[0]=__builtin_amdgcn_mfma_f32_32x32x16_bf16(PAF(2),VFR(2),o[0],0,0,0), C1,0); \
    KRD(GL,3); GAPB(o[1]=__builtin_amdgcn_mfma_f32_32x32x16_bf16(PAF(2),VFR(6),o[1],0,0,0), C1,4); \
    GAPB(o[0]=__builtin_amdgcn_mfma_f32_32x32x16_bf16(PAF(3),VFR(3),o[0],0,0,0), C1,8); \
    GAPB(o[1]=__builtin_amdgcn_mfma_f32_32x32x16_bf16(PAF(3),VFR(7),o[1],0,0,0), C1,12); \
    }while(0)
  int t=1;
  #undef CMASK
  #define CMASK(P0,P1,t) do{ if(Hook::MASK) hk.mask(P0,P1,(t),mhat); }while(0)
  for(;t+5<NT;t+=2){
    STEP(pB0,pB1,pA0,pA1,t,true,true,true);     WAIT_BAR(2); RESC(); ROT();
    STEP(pA0,pA1,pB0,pB1,t+1,true,true,true);   WAIT_BAR(2); RESC(); ROT();
  }
  #undef CMASK
  #define CMASK(P0,P1,t) do{ if(Hook::MASK) hk.mask(P0,P1,(t),mhat); }while(0)
  #define ENDW(tt) do{ if((tt)+3<NT){WAIT_BAR(2);} else if((tt)+2<NT){WAIT_BAR(1);} else {WAIT_BAR(0);} }while(0)
  for(;t+1<NT;t+=2){
    STEP(pB0,pB1,pA0,pA1,t,(t+3<NT),(t+1<NT),(t+1<NT));       ENDW(t);   RESC(); ROT();
    STEP(pA0,pA1,pB0,pB1,t+1,(t+4<NT),(t+2<NT),(t+2<NT));     ENDW(t+1); RESC(); ROT();
  }
  STEP(pB0,pB1,pA0,pA1,NT-1,false,false,false); RESC();
  { float sacc=pB0[0]+pB0[1]; _Pragma("unroll") for(int r=2;r<16;++r)sacc+=pB0[r]; _Pragma("unroll") for(int r=0;r<16;++r)sacc+=pB1[r]; l_reg+=sacc;
    pw0=(u32x4){PKW(pB0,0),PKW(pB0,2),PKW(pB0,4),PKW(pB0,6)};pw1=(u32x4){PKW(pB0,8),PKW(pB0,10),PKW(pB0,12),PKW(pB0,14)};pw2=(u32x4){PKW(pB1,0),PKW(pB1,2),PKW(pB1,4),PKW(pB1,6)};pw3=(u32x4){PKW(pB1,8),PKW(pB1,10),PKW(pB1,12),PKW(pB1,14)};
    SBAR(); pv(o,vb0+sl_cur,PAF(0),PAF(1),PAF(2),PAF(3)); }
  #undef PKW
  #undef PAF
  #undef VFR
  #undef PIN
  #undef MX3
  #undef GAPA
  #undef GAPB
  #undef EX
  #undef VRD
  #undef KRD
  #undef STEP
  #undef ENDW
  {auto rr=__builtin_amdgcn_permlane32_swap(__float_as_uint(l_reg),__float_as_uint(l_reg),false,false);l_reg=__uint_as_float(rr[0])+__uint_as_float(rr[1]);}
  if(hi==0)wsf[32+r32]=l_reg;asm volatile("s_waitcnt lgkmcnt(0)":::"memory");
  float rli[16];
  #pragma unroll
  for(int r=0;r<16;++r)rli[r]=__builtin_amdgcn_rcpf(wsf[32+crow(r,hi)]);
  bf16*Ow=Ow0+(long)(wid*QBLK)*OP;
  { bf16*stg=(bf16*)(shm+LDS_OST)+wid*2048;
    #pragma unroll
    for(int r=0;r<16;++r){const int orow=crow(r,hi);
      #pragma unroll
      for(int d0=0;d0<2;++d0)stg[orow*64+d0*32+r32]=__float2bfloat16(o[d0][r]*rli[r]);}
    asm volatile("s_waitcnt lgkmcnt(0)":::"memory");
    #pragma unroll
    for(int i=0;i<4;++i){const int row=i*8+(lane>>3),ch=lane&7; const u32x4 v=*(const u32x4*)(stg+row*64+ch*8); ATTN_STORE16(Ow+(long)row*OP+ch*8,v);} }
  asm volatile("s_waitcnt lgkmcnt(0)\n\ts_barrier":::"memory");
  #undef DMA_K
  #undef DMA_V
  #undef CMASK
  #undef START
  #undef RESC
  #undef ROT
}
constexpr int ATTN_LDS_BYTES=LDS_BYTES;
#undef SBAR
#undef WAIT_BAR
}
#define GAS __attribute__((address_space(1)))
#define LAS __attribute__((address_space(3)))
typedef unsigned short bf16;
typedef unsigned v4u __attribute__((ext_vector_type(4)));
typedef unsigned v2u __attribute__((ext_vector_type(2)));
typedef float f32x4 __attribute__((ext_vector_type(4)));
typedef float f32x2 __attribute__((ext_vector_type(2)));
#define LDS_WAIT() asm volatile("s_waitcnt lgkmcnt(0)" ::: "memory")

constexpr int NWAVES = 8;
constexpr int NB = 8, SEQ = 4096, DM = 1024, LC = 256, TB = SEQ + LC, TT = NB * TB, TX = NB * SEQ;
constexpr int NE = 32, MAXSLOT = 77824;
constexpr float EPS = 1e-6f;
constexpr float LOG2E = 1.4426950408889634f;
constexpr float C2 = 0.125f * LOG2E;
constexpr size_t MiB = 1u << 20;
constexpr size_t WS_CTL = 0, CTL_ZERO_BYTES = 1 * MiB;
constexpr size_t WS_MOD = 1 * MiB;
constexpr size_t WS_ROPE = 2 * MiB;
constexpr size_t WS_TOK = 3 * MiB;
constexpr size_t WS_SLOT = 4 * MiB;
constexpr size_t WS_CTX = 5 * MiB;
constexpr size_t WS_WINE = 13 * MiB, WS_WOUTE = 16 * MiB, WS_WINO = 18 * MiB, WS_WOUTO = 24 * MiB, WS_W13 = 26 * MiB, WS_W2 = 154 * MiB;
constexpr size_t WS_HA = 218 * MiB;
constexpr size_t WS_R1 = 286 * MiB;
constexpr size_t R1_QE = 0, R1_KE = 34 * MiB, R1_VE = 43 * MiB, R1_UE = 52 * MiB;
constexpr size_t R1_QO = 0, R1_QKV_STRIDE = 68 * MiB;
constexpr size_t R1_XPAD = 0, R1_HMID = 152 * MiB, R1_Y2 = 0;
constexpr size_t WS_END = 514 * MiB;
constexpr int LDS_BYTES = 163840, MISC_OFF = 147456;
constexpr int NA_TAB_OFF = 90112;

struct Args { const float* in[25]; float* out; unsigned char* ws; int ph_lo, ph_hi; };

__device__ __forceinline__ unsigned f2bf(float f) { unsigned u = __builtin_bit_cast(unsigned, f); return (u + 0x7fffu + ((u >> 16) & 1u)) >> 16; }
__device__ __forceinline__ unsigned pk2(float lo, float hi) { return f2bf(lo) | (f2bf(hi) << 16); }
__device__ __forceinline__ float bf2f(unsigned short h) { return __builtin_bit_cast(float, (unsigned)h << 16); }
__device__ __forceinline__ float bflo(unsigned w) { return __builtin_bit_cast(float, w << 16); }
__device__ __forceinline__ float bfhi(unsigned w) { return __builtin_bit_cast(float, w & 0xffff0000u); }
__device__ __forceinline__ float wave_sum(float v) {
#pragma unroll
    for (int o = 1; o < 64; o <<= 1) v += __shfl_xor(v, o);
    return v;
}

__device__ __forceinline__ void tr_item64(const float* __restrict__ W, int ldw, bf16* WT, int ldt, int k0, int n0, int drow0, int dcol0, LAS float* scr, int lane) {
#pragma unroll 4
    for (int i = 0; i < 16; ++i) { const int k = 4 * i + (lane >> 4), n4 = (lane & 15) * 4; const f32x4 v = *(const f32x4*)(W + (size_t)(k0 + k) * ldw + n0 + n4);
        LAS float* s = scr + k * 65 + n4; s[0] = v.x; s[1] = v.y; s[2] = v.z; s[3] = v.w; }
    LDS_WAIT(); asm volatile("" ::: "memory");
    const int c = lane & 7;
#pragma unroll
    for (int j = 0; j < 8; ++j) { const int n = (lane >> 3) + 8 * j; const LAS float* s = scr + (8 * c) * 65 + n;
        v4u o; o.x = pk2(s[0 * 65], s[1 * 65]); o.y = pk2(s[2 * 65], s[3 * 65]); o.z = pk2(s[4 * 65], s[5 * 65]); o.w = pk2(s[6 * 65], s[7 * 65]);
        *(v4u*)(WT + (size_t)(drow0 + n) * ldt + dcol0 + 8 * c) = o; }
    LDS_WAIT(); asm volatile("" ::: "memory");
}
__device__ __forceinline__ void mod_item(const Args& a, int l, int n0, int lane) {
    const float* W = a.in[4] + (size_t)l * 1024 * 6144 + n0;
    float acc[9][8];
#pragma unroll
    for (int r = 0; r < 9; ++r)
#pragma unroll
        for (int q = 0; q < 8; ++q) acc[r][q] = 0.f;
#pragma unroll 2
    for (int i = 0; i < 16; ++i) { const int k = lane + 64 * i; const f32x4 w0 = *(const f32x4*)(W + (size_t)k * 6144), w1 = *(const f32x4*)(W + (size_t)k * 6144 + 4);
#pragma unroll
        for (int r = 0; r < 9; ++r) { const float cv = (r < 8) ? a.in[1][r * 1024 + k] : a.in[3][k]; const float sv = cv / (1.0f + expf(-cv));
            acc[r][0] += sv * w0.x; acc[r][1] += sv * w0.y; acc[r][2] += sv * w0.z; acc[r][3] += sv * w0.w; acc[r][4] += sv * w1.x; acc[r][5] += sv * w1.y; acc[r][6] += sv * w1.z; acc[r][7] += sv * w1.w; } }
    float mine = 0.f;
#pragma unroll
    for (int r = 0; r < 9; ++r)
#pragma unroll
        for (int q = 0; q < 8; ++q) { const float v = wave_sum(acc[r][q]); if (lane == r * 8 + q) mine = v; }
    if (lane < 64) { const int r = lane >> 3, q = lane & 7; ((float*)(a.ws + WS_MOD))[(size_t)(l * 9 + r) * 6144 + n0 + q] = mine + a.in[5][l * 6144 + n0 + q]; }
    {
        float m8 = 0.f;
#pragma unroll
        for (int q = 0; q < 8; ++q) { const float v = wave_sum(acc[8][q]); if (lane == q) m8 = v; }
        if (lane < 8) ((float*)(a.ws + WS_MOD))[(size_t)(l * 9 + 8) * 6144 + n0 + lane] = m8 + a.in[5][l * 6144 + n0 + lane];
    }
}
__device__ __forceinline__ void weff_item(const Args& a, int item, int lane) {
    const int g = item >> 8, nb = (item >> 4) & 15, cb = item & 15; const int n = nb * 64 + lane, c0 = cb * 8;
    const float* wo = a.in[9] + (size_t)(512 + g * 128) * 1024 + n; const float* ps = a.in[13] + g * 128; const float* pw = a.in[12] + (size_t)(g * 128 + c0) * 128;
    float acc[8];
#pragma unroll
    for (int c = 0; c < 8; ++c) acc[c] = 0.f;
    for (int d = 0; d < 128; ++d) { const float wv = wo[(size_t)d * 1024] * ps[d];
#pragma unroll
        for (int c = 0; c < 8; ++c) acc[c] += pw[c * 128 + d] * wv; }
    v4u o; o.x = pk2(acc[0], acc[1]); o.y = pk2(acc[2], acc[3]); o.z = pk2(acc[4], acc[5]); o.w = pk2(acc[6], acc[7]);
    *(v4u*)((bf16*)(a.ws + WS_WOUTE) + (size_t)n * 1024 + 512 + g * 128 + c0) = o;
}
__device__ __forceinline__ void p0_prologue(const Args& a, LAS unsigned char* lds, int gw, int NGW, int wave, int lane) {
    LAS float* scr = (LAS float*)(lds + wave * 16640);
    constexpr int I_MOD = 1536, I_WINE = 320, I_WOUTE = 128, I_WINO = 768, I_WOUTO = 256, I_W1 = 8192, I_W3 = 8192, I_W2 = 8192, I_WEFF = 1024, I_ROPE = 16;
    constexpr int NITEMS = I_MOD + I_WINE + I_WOUTE + I_WINO + I_WOUTO + I_W1 + I_W3 + I_W2 + I_WEFF + I_ROPE;
    for (int it = gw; it < NITEMS; it += NGW) {
        int r = it;
        if (r < I_MOD) { mod_item(a, r / 768, (r % 768) * 8, lane); continue; } r -= I_MOD;
        if (r < I_WINE) { const int kb = r / 20, nb = r % 20; tr_item64(a.in[8], 1280, (bf16*)(a.ws + WS_WINE), 1024, kb * 64, nb * 64, nb * 64, kb * 64, scr, lane); continue; } r -= I_WINE;
        if (r < I_WOUTE) { const int kb = r / 16, nb = r % 16; tr_item64(a.in[9], 1024, (bf16*)(a.ws + WS_WOUTE), 1024, kb * 64, nb * 64, nb * 64, kb * 64, scr, lane); continue; } r -= I_WOUTE;
        if (r < I_WINO) { const int kb = r / 48, nb = r % 48; tr_item64(a.in[14], 3072, (bf16*)(a.ws + WS_WINO), 1024, kb * 64, nb * 64, nb * 64, kb * 64, scr, lane); continue; } r -= I_WINO;
        if (r < I_WOUTO) { const int kb = r / 16, nb = r % 16; tr_item64(a.in[15], 1024, (bf16*)(a.ws + WS_WOUTO), 1024, kb * 64, nb * 64, nb * 64, kb * 64, scr, lane); continue; } r -= I_WOUTO;
        if (r < I_W1 + I_W3) { const int which = r / I_W1; r -= which * I_W1; const int le = r >> 7, q = r & 127, kb = q >> 3, nb = q & 7, n0 = nb * 64;
            tr_item64(a.in[which ? 22 : 21] + (size_t)le * 1024 * 512, 512, (bf16*)(a.ws + WS_W13), 1024, kb * 64, n0, le * 1024 + (n0 >> 7) * 256 + (n0 & 127) + which * 128, kb * 64, scr, lane); continue; } r -= I_W1 + I_W3;
        if (r < I_W2) { const int le = r >> 7, q = r & 127, kb = q >> 4, nb = q & 15;
            tr_item64(a.in[23] + (size_t)le * 512 * 1024, 1024, (bf16*)(a.ws + WS_W2), 512, kb * 64, nb * 64, le * 1024 + nb * 64, kb * 64, scr, lane); continue; } r -= I_W2;
        if (r < I_WEFF) { weff_item(a, r, lane); continue; } r -= I_WEFF;
        {
            const int idx = r * 64 + lane, pos = idx >> 4, f = idx & 15; const double inv = exp2(-(double)f * (13.287712379549449 / 16.0)); const double ang = (double)pos * inv;
            ((f32x2*)(a.ws + WS_ROPE))[idx] = (f32x2){(float)cos(ang), (float)sin(ang)}; }
    }
}

template <int L> __device__ __forceinline__ void p_norm1(const Args& a, int gw, int NGW, int lane) {
    const float* mod = (const float*)(a.ws + WS_MOD); bf16* HA = (bf16*)(a.ws + WS_HA); const bf16* Y2 = (const bf16*)(a.ws + WS_R1 + R1_Y2);
    const float* gn = a.in[6] + L * 1024;
    for (int row = gw; row < TT; row += NGW) {
        const int b = row / TB, j = row - b * TB; const bool isx = j >= LC; const int mrow = isx ? b : 8;
        const float* src; float* wb = nullptr;
        if (L == 0) src = isx ? a.in[0] + ((size_t)b * SEQ + (j - LC)) * 1024 : a.in[2] + ((size_t)b * LC + j) * 1024;
        else { wb = isx ? a.out + ((size_t)b * SEQ + (j - LC)) * 1024 : (float*)(a.ws + WS_CTX) + ((size_t)b * LC + j) * 1024; src = wb; }
        f32x4 v[4];
#pragma unroll
        for (int q = 0; q < 4; ++q) v[q] = ((const f32x4*)src)[lane + 64 * q];
        if (L == 1) {
            const float* g2 = mod + (size_t)(0 * 9 + mrow) * 6144 + 5 * 1024;
#pragma unroll
            for (int q = 0; q < 4; ++q) { const v2u y0 = ((const v2u*)(Y2 + (size_t)row * 1024))[lane + 64 * q], y1 = ((const v2u*)(Y2 + (size_t)(TT + row) * 1024))[lane + 64 * q]; const f32x4 g = ((const f32x4*)g2)[lane + 64 * q];
                v[q].x += g.x * (bflo(y0.x) + bflo(y1.x)); v[q].y += g.y * (bfhi(y0.x) + bfhi(y1.x)); v[q].z += g.z * (bflo(y0.y) + bflo(y1.y)); v[q].w += g.w * (bfhi(y0.y) + bfhi(y1.y));
                ((f32x4*)wb)[lane + 64 * q] = v[q]; }
        }
        float ss = 0.f;
#pragma unroll
        for (int q = 0; q < 4; ++q) ss += (v[q].x * v[q].x + v[q].y * v[q].y) + (v[q].z * v[q].z + v[q].w * v[q].w);
        const float rstd = rsqrtf(wave_sum(ss) * (1.0f / 1024.0f) + EPS);
        const float* sh = mod + (size_t)(L * 9 + mrow) * 6144; const float* sc = sh + 1024;
#pragma unroll
        for (int q = 0; q < 4; ++q) { const f32x4 g = ((const f32x4*)gn)[lane + 64 * q], s = ((const f32x4*)sc)[lane + 64 * q], h = ((const f32x4*)sh)[lane + 64 * q];
            const f32x4 o = (v[q] * rstd * g) * (1.0f + s) + h;
            ((v2u*)(HA + (size_t)row * 1024))[lane + 64 * q] = (v2u){pk2(o.x, o.y), pk2(o.z, o.w)}; }
    }
}
__device__ __forceinline__ void p_final(const Args& a, int gw, int NGW, int lane) {
    const float* mod = (const float*)(a.ws + WS_MOD); const bf16* Y2 = (const bf16*)(a.ws + WS_R1 + R1_Y2); const float* gn = a.in[24];
    for (int xr = gw; xr < TX; xr += NGW) {
        const int b = xr / SEQ, t = xr - b * SEQ, row = b * TB + LC + t;
        float* px = a.out + (size_t)xr * 1024; const float* g2 = mod + (size_t)(1 * 9 + b) * 6144 + 5 * 1024;
        f32x4 v[4];
#pragma unroll
        for (int q = 0; q < 4; ++q) { v[q] = ((const f32x4*)px)[lane + 64 * q];
            const v2u y0 = ((const v2u*)(Y2 + (size_t)row * 1024))[lane + 64 * q], y1 = ((const v2u*)(Y2 + (size_t)(TT + row) * 1024))[lane + 64 * q]; const f32x4 g = ((const f32x4*)g2)[lane + 64 * q];
            v[q].x += g.x * (bflo(y0.x) + bflo(y1.x)); v[q].y += g.y * (bfhi(y0.x) + bfhi(y1.x)); v[q].z += g.z * (bflo(y0.y) + bflo(y1.y)); v[q].w += g.w * (bfhi(y0.y) + bfhi(y1.y)); }
        float ss = 0.f;
#pragma unroll
        for (int q = 0; q < 4; ++q) ss += (v[q].x * v[q].x + v[q].y * v[q].y) + (v[q].z * v[q].z + v[q].w * v[q].w);
        const float rstd = rsqrtf(wave_sum(ss) * (1.0f / 1024.0f) + EPS);
#pragma unroll
        for (int q = 0; q < 4; ++q) { const f32x4 g = ((const f32x4*)gn)[lane + 64 * q]; ((f32x4*)px)[lane + 64 * q] = v[q] * rstd * g; }
    }
}

__device__ __forceinline__ void p_qkprep_pool(const Args& a, int gw, int NGW, int lane) {
    bf16* QE = (bf16*)(a.ws + WS_R1 + R1_QE); bf16* KE = (bf16*)(a.ws + WS_R1 + R1_KE); const bf16* UE = (const bf16*)(a.ws + WS_R1 + R1_UE); bf16* HA = (bf16*)(a.ws + WS_HA);
    const f32x2* rope = (const f32x2*)(a.ws + WS_ROPE);
    const float qg = a.in[10][lane], kg = a.in[11][lane];
    const int axis = lane >> 5, f = lane & 15, half = (lane >> 4) & 1;
    for (int row = gw; row < TT; row += NGW) {
        const int b = row / TB, j = row - b * TB; const bool isx = j >= LC; const int t = isx ? j - LC : j;
        f32x2 cs = (f32x2){1.f, 0.f};
        if (isx) cs = rope[(axis ? (t & 63) : (t >> 6)) * 16 + f];
#pragma unroll
        for (int h = 0; h < 10; ++h) {
            bf16* p = (h < 8) ? QE + (size_t)row * 512 + h * 64 + lane : KE + (size_t)row * 128 + (h - 8) * 64 + lane;
            const float val = bf2f(*p); const float ss = wave_sum(val * val);
            float n = val * rsqrtf(ss * (1.0f / 64.0f) + EPS) * ((h < 8) ? qg : kg);
            const float other = __shfl_xor(n, 16);
            if (isx) n = half ? (other * cs.y + n * cs.x) : (n * cs.x - other * cs.y);
            if (h < 8) n *= C2;
            *p = (bf16)f2bf(n);
        }
        const int g = lane >> 4, w = 2 << g, Lq = isx ? SEQ : LC; const int lo = max(t - (w >> 1), 0), hi = min(t - (w >> 1) + w, Lq); const int base = row - t;
        float acc[8];
#pragma unroll
        for (int c = 0; c < 8; ++c) acc[c] = 0.f;
        for (int tt = lo; tt < hi; ++tt) { const v4u u = *(const v4u*)(UE + (size_t)(base + tt) * 512 + lane * 8);
            acc[0] += bflo(u.x); acc[1] += bfhi(u.x); acc[2] += bflo(u.y); acc[3] += bfhi(u.y); acc[4] += bflo(u.z); acc[5] += bfhi(u.z); acc[6] += bflo(u.w); acc[7] += bfhi(u.w); }
        const v4u u = *(const v4u*)(UE + (size_t)row * 512 + lane * 8); const float rc = 1.0f / (float)(hi - lo);
        v4u o; o.x = pk2(acc[0] * rc - bflo(u.x), acc[1] * rc - bfhi(u.x)); o.y = pk2(acc[2] * rc - bflo(u.y), acc[3] * rc - bfhi(u.y));
        o.z = pk2(acc[4] * rc - bflo(u.z), acc[5] * rc - bfhi(u.z)); o.w = pk2(acc[6] * rc - bflo(u.w), acc[7] * rc - bfhi(u.w));
        *(v4u*)(HA + (size_t)row * 1024 + 512 + lane * 8) = o;
    }
}

struct NoHook { static constexpr bool MASK = false, NEGC = true;
    __device__ __forceinline__ int tile_row(int t) const { return 64 * t; }
    __device__ __forceinline__ void mask(attn_body::f32x16&, attn_body::f32x16&, int, float) const {} };
struct NaHook { static constexpr bool MASK = true, NEGC = false;
    int rlo, nrows, rq, rs, dbase; const LAS float* tabl;
    __device__ __forceinline__ int tile_row(int t) const { return t < 4 ? 64 * t : 256 + 64 * min(rlo + t - 4, 63); }
    __device__ __forceinline__ void mask(attn_body::f32x16& p0, attn_body::f32x16& p1, int t, float mhat) const {
        if (t < 4) {
#pragma unroll
            for (int r = 0; r < 16; ++r) { p0[r] -= mhat; p1[r] -= mhat; }
            return; }
        const int kr = rlo + t - 4; const bool rowok = (t - 4 < nrows) && kr >= rs && kr < rs + 8;
        if (!rowok) {
#pragma unroll
            for (int r = 0; r < 16; ++r) { p0[r] = -INFINITY; p1[r] = -INFINITY; }
        } else {
            const LAS float* rowp = tabl + (kr - rq + 7) * 31;
#pragma unroll
            for (int r4 = 0; r4 < 16; r4 += 4) {
#pragma unroll
                for (int r = r4; r < r4 + 4; ++r) { const int kc0 = (r & 3) + 8 * (r >> 2); const int d0 = dbase + kc0, d1 = d0 + 32;
                    p0[r] = ((unsigned)d0 < 16u) ? p0[r] + (rowp[kc0] - mhat) : -INFINITY; p1[r] = ((unsigned)d1 < 16u) ? p1[r] + (rowp[kc0 + 32] - mhat) : -INFINITY; }
                __builtin_amdgcn_sched_barrier(0);
            }
        }
    }
};
__device__ __forceinline__ void p_attn_even(const Args& a, char* lds, int vcu) {
    using abf = attn_body::bf16;
    const abf* QE = (const abf*)(a.ws + WS_R1 + R1_QE); const abf* KE = (const abf*)(a.ws + WS_R1 + R1_KE); const abf* VE = (const abf*)(a.ws + WS_R1 + R1_VE); abf* HA = (abf*)(a.ws + WS_HA);
    const int b = vcu >> 5, i = vcu & 31, hq = i >> 2; const NoHook hk;
    const size_t kvo = (size_t)b * TB * 128 + (hq >> 2) * 64;
    for (int u = 0; u < 4; ++u) { const size_t row0 = (size_t)b * TB + LC + ((i & 3) * 4 + u) * 256;
        attn_body::attn_unit<8, 512, 128, 128, 1024, NoHook>(QE + row0 * 512 + hq * 64, KE + kvo, VE + kvo, HA + row0 * 1024 + hq * 64, 68, hk, lds); }
    if (i < 8) { const size_t row0 = (size_t)b * TB; const int hc = i;
        const size_t kvc = (size_t)b * TB * 128 + (hc >> 2) * 64;
        attn_body::attn_unit<8, 512, 128, 128, 1024, NoHook>(QE + row0 * 512 + hc * 64, KE + kvc, VE + kvc, HA + row0 * 1024 + hc * 64, 4, hk, lds); }
}
__device__ __forceinline__ void p_attn_na(const Args& a, char* lds, LAS unsigned char* ldsl, int vcu, int tid) {
    using abf = attn_body::bf16;
    const abf* QO = (const abf*)(a.ws + WS_R1 + R1_QO); const abf* KO = (const abf*)(a.ws + WS_R1 + R1_QO + R1_QKV_STRIDE); const abf* VO = (const abf*)(a.ws + WS_R1 + R1_QO + 2 * R1_QKV_STRIDE); abf* HA = (abf*)(a.ws + WS_HA);
    const int b = vcu >> 5, i = vcu & 31, h = i >> 1, rg0 = (i & 1) * 8;
    LAS float* tab = (LAS float*)(ldsl + NA_TAB_OFF);
    for (int k = tid; k < 640; k += 512) { const int idx = k - 64; tab[k] = (idx >= 0 && idx < 465) ? a.in[16][h * 465 + idx] * LOG2E : 0.f; }
    __syncthreads();
    const int lane = tid & 63, wid = __builtin_amdgcn_readfirstlane(tid >> 6), r32 = lane & 31, hi = lane >> 5;
    const int cq = 32 * (wid & 1) + r32, cs = min(max(cq - 8, 0), 48);
    for (int u = 0; u < 8; ++u) { const int r0 = (rg0 + u) * 4;
        NaHook hk; hk.rlo = min(max(r0 - 4, 0), 56); hk.nrows = min(max(r0 + 3 - 4, 0), 56) + 8 - hk.rlo; hk.rq = r0 + (wid >> 1); hk.rs = min(max(hk.rq - 4, 0), 56);
        hk.dbase = 4 * hi - cs; hk.tabl = tab + 64 + (4 * hi - cq + 15);
        const int NT = (4 + hk.nrows + 1) & ~1;
        const size_t row0 = (size_t)b * TB + LC + r0 * 64, kv0 = (size_t)b * TB * 1024 + h * 64;
        attn_body::attn_unit<8, 1024, 1024, 1024, 1024, NaHook>(QO + row0 * 1024 + h * 64, KO + kv0, VO + kv0, HA + row0 * 1024 + h * 64, NT, hk, lds); }
}

template <int L> __device__ __forceinline__ void p_router(const Args& a, LAS unsigned char* lds, int bid, int G, int tid) {
    const int lane = tid & 63, wave = tid >> 6;
    LAS float* Wt = (LAS float*)lds;
    LAS int* lcnt = (LAS int*)(lds + MISC_OFF); LAS int* lbase = lcnt + 32; LAS int* lE = lcnt + 64; LAS int* lR = lE + 320; LAS float* lW = (LAS float*)(lR + 320);
    const float* wg = a.in[17] + (size_t)L * 1024 * 4; const float* we = a.in[19] + (size_t)L * 1024 * 32;
    for (int k = tid; k < 1024; k += 512) {
#pragma unroll
        for (int e = 0; e < 4; ++e) Wt[e * 1024 + k] = wg[k * 4 + e];
#pragma unroll 8
        for (int e = 0; e < 32; ++e) Wt[(4 + e) * 1024 + k] = we[k * 32 + e];
    }
    if (tid < 32) lcnt[tid] = 0;
    __syncthreads();
    const float* mod = (const float*)(a.ws + WS_MOD); bf16* HA = (bf16*)(a.ws + WS_HA); const float* gn = a.in[7] + L * 1024;
    const float* bg = a.in[18] + L * 4; const float* be = a.in[20] + L * 32;
    constexpr int NPAIR = (L == 0) ? TT / 2 : TX / 2;
    const int ppb = (NPAIR + G - 1) / G;
    const int p_lo = bid * ppb, p_hi = min(p_lo + ppb, NPAIR);
    for (int p = p_lo + wave; p < p_hi; p += NWAVES) {
        int row;
        if (L == 0) row = 2 * p; else { const int bb = p / (SEQ / 2); row = bb * TB + LC + 2 * (p - bb * (SEQ / 2)); }
        const int b = row / TB, j = row - b * TB; const bool isx = j >= LC; const int mrow = isx ? b : 8;
        const float* src = isx ? a.out + ((size_t)b * SEQ + (j - LC)) * 1024 : (const float*)(a.ws + WS_CTX) + ((size_t)b * LC + j) * 1024;
        f32x4 xa[4], xb[4]; float ssa = 0.f, ssb = 0.f;
#pragma unroll
        for (int q = 0; q < 4; ++q) { xa[q] = ((const f32x4*)src)[lane + 64 * q]; xb[q] = ((const f32x4*)(src + 1024))[lane + 64 * q];
            ssa += (xa[q].x * xa[q].x + xa[q].y * xa[q].y) + (xa[q].z * xa[q].z + xa[q].w * xa[q].w); ssb += (xb[q].x * xb[q].x + xb[q].y * xb[q].y) + (xb[q].z * xb[q].z + xb[q].w * xb[q].w); }
        const float ra = rsqrtf(wave_sum(ssa) * (1.0f / 1024.0f) + EPS), rb = rsqrtf(wave_sum(ssb) * (1.0f / 1024.0f) + EPS);
        const float* sh = mod + (size_t)(L * 9 + mrow) * 6144 + 3 * 1024; const float* sc = sh + 1024;
#pragma unroll
        for (int q = 0; q < 4; ++q) { const f32x4 g = ((const f32x4*)gn)[lane + 64 * q], s = ((const f32x4*)sc)[lane + 64 * q], h = ((const f32x4*)sh)[lane + 64 * q];
            xa[q] = (xa[q] * ra * g) * (1.0f + s) + h; xb[q] = (xb[q] * rb * g) * (1.0f + s) + h;
            ((v2u*)(HA + (size_t)row * 1024))[lane + 64 * q] = (v2u){pk2(xa[q].x, xa[q].y), pk2(xa[q].z, xa[q].w)};
            ((v2u*)(HA + (size_t)(row + 1) * 1024))[lane + 64 * q] = (v2u){pk2(xb[q].x, xb[q].y), pk2(xb[q].z, xb[q].w)}; }
        float ma = 0.f, mb = 0.f;
#pragma unroll
        for (int e = 0; e < 36; ++e) { float pa = 0.f, pb = 0.f;
#pragma unroll
            for (int q = 0; q < 4; ++q) { const f32x4 w = *(const LAS f32x4*)(Wt + e * 1024 + 4 * lane + 256 * q);
                pa += (xa[q].x * w.x + xa[q].y * w.y) + (xa[q].z * w.z + xa[q].w * w.w); pb += (xb[q].x * w.x + xb[q].y * w.y) + (xb[q].z * w.z + xb[q].w * w.w); }
            const float va = wave_sum(pa), vb = wave_sum(pb); if (lane == e) { ma = va; mb = vb; } }
#pragma unroll
        for (int r2 = 0; r2 < 2; ++r2) {
            const int mm = __builtin_bit_cast(int, r2 ? mb : ma);
            float gl[4]; int gi = 0;
#pragma unroll
            for (int e = 0; e < 4; ++e) gl[e] = __builtin_bit_cast(float, __builtin_amdgcn_readlane(mm, e)) + bg[e];
            float gm = gl[0];
#pragma unroll
            for (int e = 1; e < 4; ++e) if (gl[e] > gm) { gm = gl[e]; gi = e; }
            float gs = 0.f;
#pragma unroll
            for (int e = 0; e < 4; ++e) gs += expf(gl[e] - gm);
            const float gwt = 1.0f / gs;
            float el[8];
#pragma unroll
            for (int e = 0; e < 8; ++e) el[e] = __builtin_bit_cast(float, __builtin_amdgcn_readlane(mm, 4 + gi * 8 + e)) + be[gi * 8 + e];
            int i0 = 0; float m0 = el[0];
#pragma unroll
            for (int e = 1; e < 8; ++e) if (el[e] > m0) { m0 = el[e]; i0 = e; }
            int i1 = -1; float m1 = -INFINITY;
#pragma unroll
            for (int e = 0; e < 8; ++e) if (e != i0 && el[e] > m1) { m1 = el[e]; i1 = e; }
            const float ex = expf(m1 - m0), p0 = 1.0f / (1.0f + ex), p1 = ex * p0;
            if (lane == 0) { const int e0 = gi * 8 + i0, e1 = gi * 8 + i1; const int li = ((p - p_lo) * 2 + r2) * 2;
                lE[li] = e0; lR[li] = __hip_atomic_fetch_add(&lcnt[e0], 1, __ATOMIC_RELAXED, __HIP_MEMORY_SCOPE_WORKGROUP); lW[li] = gwt * p0;
                lE[li + 1] = e1; lR[li + 1] = __hip_atomic_fetch_add(&lcnt[e1], 1, __ATOMIC_RELAXED, __HIP_MEMORY_SCOPE_WORKGROUP); lW[li + 1] = gwt * p1; }
        }
    }
    __syncthreads();
    if (tid < 32) lbase[tid] = atomicAdd((int*)(a.ws + WS_CTL) + L * 32 + tid, lcnt[tid]);
    __syncthreads();
    int* tokE = (int*)(a.ws + WS_TOK); int* tokR = tokE + 2 * TT; float* tokW = (float*)(tokR + 2 * TT);
    const int nas = (p_hi - p_lo) * 4;
    if (tid < nas) { const int p = p_lo + (tid >> 2), r2 = (tid >> 1) & 1, k = tid & 1; int row;
        if (L == 0) row = 2 * p; else { const int bb = p / (SEQ / 2); row = bb * TB + LC + 2 * (p - bb * (SEQ / 2)); }
        row += r2; const int e = lE[tid]; tokE[row * 2 + k] = e; tokR[row * 2 + k] = lR[tid] + lbase[e]; tokW[row * 2 + k] = lW[tid]; }
}
__device__ __forceinline__ void moe_tiles(const Args& a, LAS unsigned char* lds, int L, int tid) {
    LAS int* tstart = (LAS int*)(lds + MISC_OFF + 4096);
    if (tid == 0) { const int* cnt = (const int*)(a.ws + WS_CTL) + L * 32; int t = 0; for (int e = 0; e < 32; ++e) { tstart[e] = t; t += (cnt[e] + 255) >> 8; } tstart[32] = t; }
    __syncthreads();
}
template <int L> __device__ __forceinline__ void p_gather(const Args& a, LAS unsigned char* lds, int bid, int gw, int NGW, int tid) {
    const int lane = tid & 63;
    moe_tiles(a, lds, L, tid);
    const LAS int* tstart = (const LAS int*)(lds + MISC_OFF + 4096);
    int* dstrow = (int*)(a.ws + WS_SLOT); float* wgt = (float*)(dstrow + MAXSLOT);
    const int* tokE = (const int*)(a.ws + WS_TOK); const int* tokR = tokE + 2 * TT; const float* tokW = (const float*)(tokR + 2 * TT);
    const bf16* HA = (const bf16*)(a.ws + WS_HA); bf16* XP = (bf16*)(a.ws + WS_R1 + R1_XPAD);
    if (bid < 32) { const int e = bid, cnt = ((const int*)(a.ws + WS_CTL))[L * 32 + e]; for (int s = tstart[e] * 256 + cnt + tid; s < tstart[e + 1] * 256; s += 512) dstrow[s] = -1; }
    constexpr int NR = (L == 0) ? TT : TX;
    for (int r = gw; r < NR; r += NGW) {
        int row; if (L == 0) row = r; else { const int bb = r / SEQ; row = bb * TB + LC + (r - bb * SEQ); }
        const v4u h0 = *(const v4u*)(HA + (size_t)row * 1024 + lane * 8), h1 = *(const v4u*)(HA + (size_t)row * 1024 + 512 + lane * 8);
#pragma unroll
        for (int k = 0; k < 2; ++k) { const int e = tokE[row * 2 + k]; const int dest = tstart[e] * 256 + tokR[row * 2 + k];
            *(v4u*)(XP + (size_t)dest * 1024 + lane * 8) = h0; *(v4u*)(XP + (size_t)dest * 1024 + 512 + lane * 8) = h1;
            if (lane == 0) { dstrow[dest] = k * TT + row; wgt[dest] = tokW[row * 2 + k]; } }
    }
}

constexpr int NPH = 19;
__global__ void __launch_bounds__(NWAVES * 64, 2) mega_fwd(Args args) {
    extern __shared__ __attribute__((aligned(16))) unsigned char lds_raw[];
    LAS unsigned char* lds = (LAS unsigned char*)lds_raw;
    const int tid = threadIdx.x, lane = tid & 63, wave = __builtin_amdgcn_readfirstlane(tid >> 6);
    const int G = gridDim.x, bid = blockIdx.x; const int vcu = (G % 8 == 0) ? (bid % 8) * (G / 8) + bid / 8 : bid;
    const int gw = vcu * NWAVES + wave, NGW = G * NWAVES;
    const int lo = args.ph_lo, hi = args.ph_hi;
    unsigned char* ws = args.ws;
    cg::grid_group grid = cg::this_grid();
#ifndef PHASE_MASK
#define PHASE_MASK 0x7ffffu
#endif
#define IN(k) ((((PHASE_MASK) >> (k)) & 1u) && lo <= (k) && (k) < hi)
#define SEAM(k) do { if (IN(k) && IN((k) + 1)) grid.sync(); } while (0)
    typedef pg8::bf16_t pbf;
    if (IN(0)) { p0_prologue(args, lds, gw, NGW, wave, lane); } SEAM(0);
    if (IN(1)) { p_norm1<0>(args, gw, NGW, lane); } SEAM(1);
    if (IN(2)) {
        pg8::Gemm g{(const pbf*)(ws + WS_HA), (const pbf*)(ws + WS_WINE), TT, 1280, 1024}; pg8::DenseOrder S; S.init(136, 5, G, bid, 0);
        pg8::EpiEvenIn E{(pbf*)(ws + WS_R1 + R1_QE), (pbf*)(ws + WS_R1 + R1_KE), (pbf*)(ws + WS_R1 + R1_VE), (pbf*)(ws + WS_R1 + R1_UE)};
        pg8::gemm_phase<pg8::EpiEvenIn, pg8::DenseOrder, true, true>(lds, g, S, E); } SEAM(2);
    if (IN(3)) { p_qkprep_pool(args, gw, NGW, lane); } SEAM(3);
    if (IN(4)) { p_attn_even(args, (char*)lds_raw, vcu); } SEAM(4);
    if (IN(5)) {
        pg8::Gemm g{(const pbf*)(ws + WS_HA), (const pbf*)(ws + WS_WOUTE), TT, 1024, 1024}; pg8::DenseOrder S; S.init(136, 4, G, bid, 0);
        pg8::EpiResid E{args.in[0], args.in[2], args.out, (float*)(ws + WS_CTX), (const float*)(ws + WS_MOD) + 2 * 1024};
        pg8::gemm_phase<pg8::EpiResid, pg8::DenseOrder, true, true>(lds, g, S, E); } SEAM(5);
    if (IN(6)) { p_router<0>(args, lds, bid, G, tid); } SEAM(6);
    if (IN(7)) { p_gather<0>(args, lds, bid, gw, NGW, tid); } SEAM(7);
    if (IN(8)) {
        moe_tiles(args, lds, 0, tid); const LAS int* tstart = (const LAS int*)(lds + MISC_OFF + 4096);
        pg8::Gemm g{(const pbf*)(ws + WS_R1 + R1_XPAD), (const pbf*)(ws + WS_W13), 0, 0, 1024}; pg8::MoeOrder S{tstart, tstart[32] * 4, G, bid, 0};
        pg8::EpiMoeUp E{(pbf*)(ws + WS_R1 + R1_HMID)};
        pg8::gemm_phase<pg8::EpiMoeUp, pg8::MoeOrder, true, true>(lds, g, S, E); } SEAM(8);
    if (IN(9)) {
        moe_tiles(args, lds, 0, tid); const LAS int* tstart = (const LAS int*)(lds + MISC_OFF + 4096);
        pg8::Gemm g{(const pbf*)(ws + WS_R1 + R1_HMID), (const pbf*)(ws + WS_W2), 0, 0, 512}; pg8::MoeOrder S{tstart, tstart[32] * 4, G, bid, 0};
        pg8::EpiMoeDown E{(pbf*)(ws + WS_R1 + R1_Y2), (const int*)(ws + WS_SLOT), (const float*)(ws + WS_SLOT) + MAXSLOT};
        pg8::gemm_phase<pg8::EpiMoeDown, pg8::MoeOrder, true, true>(lds, g, S, E); } SEAM(9);
    if (IN(10)) { p_norm1<1>(args, gw, NGW, lane); } SEAM(10);
    if (IN(11)) {
        pg8::Gemm g{(const pbf*)(ws + WS_HA), (const pbf*)(ws + WS_WINO), TT, 3072, 1024}; pg8::DenseOrder S; S.init(128, 12, G, bid, 1, 64, 4, 8);
        pg8::EpiBf16 E{(pbf*)(ws + WS_R1 + R1_QO), 1024, 1024, R1_QKV_STRIDE / 2, C2};
        pg8::gemm_phase<pg8::EpiBf16, pg8::DenseOrder, true, true>(lds, g, S, E); } SEAM(11);
    if (IN(12)) { p_attn_na(args, (char*)lds_raw, lds, vcu, tid); } SEAM(12);
    if (IN(13)) {
        pg8::Gemm g{(const pbf*)(ws + WS_HA), (const pbf*)(ws + WS_WOUTO), TT, 1024, 1024}; pg8::DenseOrder S; S.init(128, 4, G, bid, 1);
        pg8::EpiResid E{args.out, (const float*)(ws + WS_CTX), args.out, (float*)(ws + WS_CTX), (const float*)(ws + WS_MOD) + 9 * 6144 + 2 * 1024};
        pg8::gemm_phase<pg8::EpiResid, pg8::DenseOrder, true, true>(lds, g, S, E); } SEAM(13);
    if (IN(14)) { p_router<1>(args, lds, bid, G, tid); } SEAM(14);
    if (IN(15)) { p_gather<1>(args, lds, bid, gw, NGW, tid); } SEAM(15);
    if (IN(16)) {
        moe_tiles(args, lds, 1, tid); const LAS int* tstart = (const LAS int*)(lds + MISC_OFF + 4096);
        pg8::Gemm g{(const pbf*)(ws + WS_R1 + R1_XPAD), (const pbf*)(ws + WS_W13), 0, 0, 1024}; pg8::MoeOrder S{tstart, tstart[32] * 4, G, bid, 32};
        pg8::EpiMoeUp E{(pbf*)(ws + WS_R1 + R1_HMID)};
        pg8::gemm_phase<pg8::EpiMoeUp, pg8::MoeOrder, true, true>(lds, g, S, E); } SEAM(16);
    if (IN(17)) {
        moe_tiles(args, lds, 1, tid); const LAS int* tstart = (const LAS int*)(lds + MISC_OFF + 4096);
        pg8::Gemm g{(const pbf*)(ws + WS_R1 + R1_HMID), (const pbf*)(ws + WS_W2), 0, 0, 512}; pg8::MoeOrder S{tstart, tstart[32] * 4, G, bid, 32};
        pg8::EpiMoeDown E{(pbf*)(ws + WS_R1 + R1_Y2), (const int*)(ws + WS_SLOT), (const float*)(ws + WS_SLOT) + MAXSLOT};
        pg8::gemm_phase<pg8::EpiMoeDown, pg8::MoeOrder, true, true>(lds, g, S, E); } SEAM(17);
    if (IN(18)) { p_final(args, gw, NGW, lane); }
#undef IN
#undef SEAM
}

#ifndef MK_PER_PHASE
#define MK_PER_PHASE 0
#endif
extern "C" void kernel_launch(void* const* d_in, const int* in_sizes, int n_in, void* d_out, int out_size, void* d_ws, size_t ws_size, hipStream_t stream) {
    static int grid = 0;
    if (grid == 0) {
        if (n_in != 25 || in_sizes[0] != TX * DM || out_size != TX * DM || ws_size < WS_END) { fprintf(stderr, "kernel_launch: unexpected shapes/workspace: n_in %d in0 %d out %d ws %zu (need %zu)\n", n_in, n_in > 0 ? in_sizes[0] : -1, out_size, ws_size, (size_t)WS_END); grid = -1; return; }
        int dev = 0, cus = 0, per_cu = 0;
        if (hipGetDevice(&dev) != hipSuccess || hipDeviceGetAttribute(&cus, hipDeviceAttributeMultiprocessorCount, dev) != hipSuccess) { grid = -1; return; }
        if (hipFuncSetAttribute((const void*)mega_fwd, hipFuncAttributeMaxDynamicSharedMemorySize, LDS_BYTES) != hipSuccess) { fprintf(stderr, "kernel_launch: hipFuncSetAttribute failed\n"); grid = -1; return; }
        if (hipOccupancyMaxActiveBlocksPerMultiprocessor(&per_cu, (const void*)mega_fwd, NWAVES * 64, LDS_BYTES) != hipSuccess || per_cu < 1) { fprintf(stderr, "kernel_launch: occupancy query says %d blocks per CU\n", per_cu); grid = -1; return; }
        if (cus != 256) { fprintf(stderr, "kernel_launch: built for 256 CUs, found %d\n", cus); grid = -1; return; }
        grid = cus;
    }
    if (grid < 0) return;
    (void)hipMemsetAsync((char*)d_ws + WS_CTL, 0, CTL_ZERO_BYTES, stream);
    Args a{};
    for (int i = 0; i < 25; ++i) a.in[i] = (const float*)d_in[i];
    a.out = (float*)d_out; a.ws = (unsigned char*)d_ws;
#if MK_PER_PHASE
    for (int p = 0; p < NPH; ++p) { a.ph_lo = p; a.ph_hi = p + 1; void* kargs[] = {&a};
        hipError_t e = hipLaunchCooperativeKernel((const void*)mega_fwd, dim3(grid), dim3(NWAVES * 64), kargs, LDS_BYTES, stream);
        if (e != hipSuccess) { fprintf(stderr, "kernel_launch: launch %d failed: %s\n", p, hipGetErrorString(e)); break; } }
#else
    a.ph_lo = 0; a.ph_hi = NPH; void* kargs[] = {&a};
    hipError_t e = hipLaunchCooperativeKernel((const void*)mega_fwd, dim3(grid), dim3(NWAVES * 64), kargs, LDS_BYTES, stream);
    if (e != hipSuccess) fprintf(stderr, "kernel_launch: cooperative launch failed: %s\n", hipGetErrorString(e));
#endif
}
```

```cpp
#include <hip/hip_runtime.h>
#include <hip/hip_cooperative_groups.h>
#include <hip/hip_bf16.h>
#include <cstdio>
#include <cstdint>
#include <cmath>
namespace cg = cooperative_groups;
namespace pg8 {
#define PG8_LAS __attribute__((address_space(3)))
typedef unsigned short bf16_t;
typedef short bf16x8 __attribute__((ext_vector_type(8)));
typedef float f32x4 __attribute__((ext_vector_type(4)));
typedef unsigned u32x4 __attribute__((ext_vector_type(4)));
constexpr int BM = 256, BK = 64, HALF = 128, HTB = HALF * BK * 2  , STAGE_BYTES = 8 * HTB, NXCD = 8, WGM = 8;

__host__ __device__ __forceinline__ int lds_byte(int r, int c) { const int st = (r >> 4) * 2 + (c >> 5), rr = r & 15, cc = c & 31, ob = rr * 64 + cc * 2; return st * 1024 + (ob ^ (((ob >> 9) & 1) << 5)); }
__host__ __device__ __forceinline__ void stage_rc(int b, int& R, int& C) { const int st = b / 1024, sb = b % 1024, swz = sb ^ (((sb >> 9) & 1) << 5); R = (st >> 1) * 16 + swz / 64; C = (st & 1) * 32 + (swz % 64) / 2; }
__host__ __device__ __forceinline__ int perm32(int rho) { const int n = rho >> 4, i = rho & 15; return 8 * (i >> 2) + 4 * n + (i & 3); }

struct Unit { int pm, pn, e, lt; };
struct Gemm { const bf16_t* A; const bf16_t* Bt; int M, N, K; };

struct StaticOrder {
    int nM, nN, nwg, G, c;
    __host__ __device__ void init(int M, int N, int G_, int c_) { nM = M / BM; nN = N / BM; nwg = nM * nN; G = G_; c = c_; }
    __host__ __device__ bool next(int i, Unit& u) const {
        const long L = (long)i * G + c; if (L >= nwg) return false;
        int wgid = (int)L; { const int q = nwg / NXCD, r = nwg % NXCD, xcd = wgid % NXCD, off = wgid / NXCD; wgid = (xcd < r ? xcd * (q + 1) : r * (q + 1) + (xcd - r) * q) + off; }
        const int nig = WGM * nN, gid = wgid / nig, fm = gid * WGM, gsz = (nM - fm) < WGM ? (nM - fm) : WGM;
        u.pm = fm + ((wgid % nig) % gsz); u.pn = (wgid % nig) / gsz; return true;
    }
    __device__ __forceinline__ void a_ready(const Unit&) const {}
    __device__ __forceinline__ void done(const Unit&) const {}
};

__device__ __forceinline__ unsigned cvt_pk_bf16(float lo, float hi) { unsigned r; asm volatile("v_cvt_pk_bf16_f32 %0, %1, %2" : "=v"(r) : "v"(lo), "v"(hi)); return r; }
typedef float f32x2 __attribute__((ext_vector_type(2)));
struct DenseOrder {
    int nM, nN, nwg, G, c, mode, n2, pn2_0, nN2;
    __device__ __forceinline__ void init(int nM_, int nN_, int G_, int c_, int mode_, int n2_ = 0, int pn2_0_ = 0, int nN2_ = 1) { nM = nM_; nN = nN_; nwg = nM * nN; G = G_; c = c_; mode = mode_; n2 = n2_; pn2_0 = pn2_0_; nN2 = nN2_; }
    __device__ __forceinline__ bool next(int i, Unit& u) const {
        long L = (long)i * G + c;
        if (L < nwg) {
            int wgid = (int)L; { const int q = nwg / NXCD, r = nwg % NXCD, xcd = wgid % NXCD, off = wgid / NXCD; wgid = (xcd < r ? xcd * (q + 1) : r * (q + 1) + (xcd - r) * q) + off; }
            const int nig = WGM * nN, gid = wgid / nig, fm = gid * WGM, gsz = (nM - fm) < WGM ? (nM - fm) : WGM;
            int pm = fm + ((wgid % nig) % gsz); u.pn = (wgid % nig) / gsz;
            if (mode == 1) pm = pm + pm / 16 + 1;
            u.pm = pm; return true;
        }
        L -= nwg; if (L >= n2) return false;
        u.pm = 17 * (int)(L / nN2); u.pn = pn2_0 + (int)(L % nN2); return true;
    }
    __device__ __forceinline__ void a_ready(const Unit&) const {}
    __device__ __forceinline__ void done(const Unit&) const {}
};
struct MoeOrder {
    const PG8_LAS int* tstart; int nunits, G, c, ebase;
    __device__ __forceinline__ bool next(int i, Unit& u) const {
        const long L = (long)i * G + c; if (L >= nunits) return false;
        const int tile = (int)(L >> 2), j = (int)(L & 3); int e = 0;
#pragma unroll
        for (int k = 1; k < 32; ++k) e += (tile >= tstart[k]) ? 1 : 0;
        u.pm = tile; u.pn = (ebase + e) * 4 + j; u.e = e; u.lt = tile - tstart[e]; return true;
    }
    __device__ __forceinline__ void a_ready(const Unit&) const {}
    __device__ __forceinline__ void done(const Unit&) const {}
};

struct EpiBf16 {
    static constexpr bool PERM = true, AFTER_DRAIN = false;
    struct State {}; __device__ __forceinline__ void prefetch(const Unit&, State&, int) const {} __device__ __forceinline__ void stash(const State&, int, int) const {}
    bf16_t* O; int ldc; int split_cols; size_t split_stride; float scale0; unsigned long long* tsp = nullptr;
    __device__ __forceinline__ void operator()(const f32x4 (&acc)[2][2][4][2], const Unit& u, int wr, int wc, int fr, int fq, int ui = 0) const {
        const int row0 = u.pm * BM + wr * 64 + fr; int colt = u.pn * BM; bf16_t* base = O;
        float sc = 1.f; if (split_cols) { const int t = colt / split_cols; base += (size_t)t * split_stride; colt -= t * split_cols; if (t == 0) sc = scale0; }
        const int col0 = colt + wc * 32 + 8 * fq;
#pragma unroll
        for (int ai = 0; ai < 2; ++ai)
#pragma unroll
            for (int m = 0; m < 4; ++m) { bf16_t* rowp = base + (size_t)(row0 + ai * HALF + m * 16) * ldc + col0;
#pragma unroll
                for (int bj = 0; bj < 2; ++bj) { f32x4 v0 = acc[ai][bj][m][0] * sc, v1 = acc[ai][bj][m][1] * sc;
                    u32x4 w; w.x = cvt_pk_bf16(v0[0], v0[1]); w.y = cvt_pk_bf16(v0[2], v0[3]); w.z = cvt_pk_bf16(v1[0], v1[1]); w.w = cvt_pk_bf16(v1[2], v1[3]);
                    *(u32x4*)(rowp + bj * HALF) = w; } }
    }
};
struct EpiOddIn {
    static constexpr bool PERM = true, AFTER_DRAIN = false;
    struct State {}; __device__ __forceinline__ void prefetch(const Unit&, State&, int) const {} __device__ __forceinline__ void stash(const State&, int, int) const {}
    bf16_t *Q, *K, *V; float qscale; unsigned long long* tsp = nullptr;
    __device__ __forceinline__ void operator()(const f32x4 (&acc)[2][2][4][2], const Unit& u, int wr, int wc, int fr, int fq, int ui = 0) const {
        const int cw = wc * 32 + 8 * fq, rl0 = wr * 64 + fr;
        if (u.pn < 4) {
#pragma unroll
            for (int ai = 0; ai < 2; ++ai)
#pragma unroll
                for (int m = 0; m < 4; ++m) { bf16_t* rowp = Q + (size_t)(u.pm * BM + rl0 + ai * HALF + m * 16) * 1024 + u.pn * 256 + cw;
#pragma unroll
                    for (int bj = 0; bj < 2; ++bj) { const f32x4 v0 = acc[ai][bj][m][0] * qscale, v1 = acc[ai][bj][m][1] * qscale;
                        u32x4 w; w.x = cvt_pk_bf16(v0[0], v0[1]); w.y = cvt_pk_bf16(v0[2], v0[3]); w.z = cvt_pk_bf16(v1[0], v1[1]); w.w = cvt_pk_bf16(v1[2], v1[3]);
                        *(u32x4*)(rowp + bj * HALF) = w; } }
        } else {
            bf16_t* base = (u.pn < 8) ? K : V; const int ct = (u.pn & 3) * 256, b = u.pm / 17, rb = (u.pm - b * 17) * 256 + rl0;
#pragma unroll
            for (int bj = 0; bj < 2; ++bj) { const int col = ct + bj * HALF + cw, h = col >> 6, d = col & 63; bf16_t* hp = base + ((size_t)(b * 16 + h) * 4352) * 64 + d;
#pragma unroll
                for (int ai = 0; ai < 2; ++ai)
#pragma unroll
                    for (int m = 0; m < 4; ++m) { const f32x4 v0 = acc[ai][bj][m][0], v1 = acc[ai][bj][m][1];
                        u32x4 w; w.x = cvt_pk_bf16(v0[0], v0[1]); w.y = cvt_pk_bf16(v0[2], v0[3]); w.z = cvt_pk_bf16(v1[0], v1[1]); w.w = cvt_pk_bf16(v1[2], v1[3]);
                        *(u32x4*)(hp + (size_t)(rb + ai * HALF + m * 16) * 64) = w; } }
        }
    }
};
struct EpiEvenIn {
    static constexpr bool PERM = true, AFTER_DRAIN = false;
    struct State {}; __device__ __forceinline__ void prefetch(const Unit&, State&, int) const {} __device__ __forceinline__ void stash(const State&, int, int) const {}
    bf16_t *Q, *K, *V, *U; unsigned long long* tsp = nullptr;
    __device__ __forceinline__ void operator()(const f32x4 (&acc)[2][2][4][2], const Unit& u, int wr, int wc, int fr, int fq, int ui = 0) const {
        const int row0 = u.pm * BM + wr * 64 + fr, cw = wc * 32 + 8 * fq;
#pragma unroll
        for (int bj = 0; bj < 2; ++bj) {
            bf16_t* base; int ldc, col;
            if (u.pn < 2) { base = Q; ldc = 512; col = u.pn * 256 + bj * HALF + cw; }
            else if (u.pn == 2) { base = bj ? V : K; ldc = 128; col = cw; }
            else { base = U; ldc = 512; col = (u.pn - 3) * 256 + bj * HALF + cw; }
#pragma unroll
            for (int ai = 0; ai < 2; ++ai)
#pragma unroll
                for (int m = 0; m < 4; ++m) { const f32x4 v0 = acc[ai][bj][m][0], v1 = acc[ai][bj][m][1];
                    u32x4 w; w.x = cvt_pk_bf16(v0[0], v0[1]); w.y = cvt_pk_bf16(v0[2], v0[3]); w.z = cvt_pk_bf16(v1[0], v1[1]); w.w = cvt_pk_bf16(v1[2], v1[3]);
                    *(u32x4*)(base + (size_t)(row0 + ai * HALF + m * 16) * ldc + col) = w; }
        }
    }
};
struct EpiResid {
    static constexpr bool PERM = false, AFTER_DRAIN = false;
    struct State {}; __device__ __forceinline__ void prefetch(const Unit&, State&, int) const {} __device__ __forceinline__ void stash(const State&, int, int) const {}
    const float* xin; const float* cin; float* xout; float* cout; const float* modg; unsigned long long* tsp = nullptr;
    __device__ __forceinline__ void operator()(const f32x4 (&acc)[2][2][4][2], const Unit& u, int wr, int wc, int fr, int fq, int ui = 0) const {
        const int b = u.pm / 17, j = u.pm - b * 17;
        const float* src; float* dst; const float* g;
        if (j == 0) { src = cin + (size_t)b * 256 * 1024; dst = cout + (size_t)b * 256 * 1024; g = modg + 8 * 6144; }
        else { const size_t o = ((size_t)b * 4096 + (size_t)(j - 1) * 256) * 1024; src = xin + o; dst = xout + o; g = modg + b * 6144; }
        const int row0 = wr * 64 + fr, col0 = u.pn * BM + wc * 32 + 4 * fq;
        f32x4 gv[2][2];
#pragma unroll
        for (int bj = 0; bj < 2; ++bj)
#pragma unroll
            for (int n = 0; n < 2; ++n) gv[bj][n] = *(const f32x4*)(g + col0 + bj * HALF + n * 16);
#pragma unroll
        for (int ai = 0; ai < 2; ++ai)
#pragma unroll
            for (int m = 0; m < 4; ++m) { const size_t off = (size_t)(row0 + ai * HALF + m * 16) * 1024 + col0;
#pragma unroll
                for (int bj = 0; bj < 2; ++bj)
#pragma unroll
                    for (int n = 0; n < 2; ++n) { const f32x4 s = *(const f32x4*)(src + off + bj * HALF + n * 16); *(f32x4*)(dst + off + bj * HALF + n * 16) = s + gv[bj][n] * acc[ai][bj][m][n]; } }
    }
};
struct EpiMoeUp {
    static constexpr bool PERM = true, AFTER_DRAIN = false;
    struct State {}; __device__ __forceinline__ void prefetch(const Unit&, State&, int) const {} __device__ __forceinline__ void stash(const State&, int, int) const {}
    bf16_t* H; unsigned long long* tsp = nullptr;
    __device__ __forceinline__ static float silu_mul(float a, float b) { return a * __builtin_amdgcn_rcpf(1.0f + __expf(-a)) * b; }
    __device__ __forceinline__ void operator()(const f32x4 (&acc)[2][2][4][2], const Unit& u, int wr, int wc, int fr, int fq, int ui = 0) const {
        const int row0 = u.pm * BM + wr * 64 + fr, col = (u.pn & 3) * 128 + wc * 32 + 8 * fq;
#pragma unroll
        for (int ai = 0; ai < 2; ++ai)
#pragma unroll
            for (int m = 0; m < 4; ++m) { const f32x4 a0 = acc[ai][0][m][0], a1 = acc[ai][0][m][1], b0 = acc[ai][1][m][0], b1 = acc[ai][1][m][1];
                u32x4 w; w.x = cvt_pk_bf16(silu_mul(a0[0], b0[0]), silu_mul(a0[1], b0[1])); w.y = cvt_pk_bf16(silu_mul(a0[2], b0[2]), silu_mul(a0[3], b0[3]));
                w.z = cvt_pk_bf16(silu_mul(a1[0], b1[0]), silu_mul(a1[1], b1[1])); w.w = cvt_pk_bf16(silu_mul(a1[2], b1[2]), silu_mul(a1[3], b1[3]));
                *(u32x4*)(H + (size_t)(row0 + ai * HALF + m * 16) * 512 + col) = w; }
    }
};
constexpr int MOE_TT = 34816, MOE_CAP = 34816;
struct MoeGather {
    static constexpr bool GATHER = true;
    const int* elist; const PG8_LAS int* cnt;
    __device__ __forceinline__ void get(const Unit& u, const int (&sR)[2], unsigned& p0, unsigned& p1) const {
        const int c = cnt[u.e] - u.lt * 256; const int* el = elist + u.e * MOE_CAP + u.lt * 256;
        unsigned v[4];
#pragma unroll
        for (int i = 0; i < 4; ++i) { const int r = (i >> 1) * 128 + sR[i & 1]; int t = (r < c) ? el[r] : 0; t = (t >= MOE_TT) ? t - MOE_TT : t; v[i] = (unsigned)t; }
        p0 = v[0] | (v[1] << 16); p1 = v[2] | (v[3] << 16);
    }
};
struct EpiMoeDown {
    static constexpr bool PERM = true, AFTER_DRAIN = false;
    bf16_t* Y; const int* elist; const float* ewgt; const PG8_LAS int* cnt; PG8_LAS int* lrow; unsigned long long* tsp = nullptr;
    struct State { int d; float w; };
    __device__ __forceinline__ void prefetch(const Unit& u, State& st, int tid) const {
        if (tid < 256) { const int c = cnt[u.e] - u.lt * 256, lo = u.e * MOE_CAP + u.lt * 256, rc = min(tid, c - 1); st.d = (tid < c) ? elist[lo + rc] : -1; st.w = ewgt[lo + rc]; } }
    __device__ __forceinline__ void stash(const State& st, int ui, int tid) const {
        if (tid < 256) { lrow[(ui & 1) * 256 + tid] = st.d; ((PG8_LAS float*)(lrow + 512))[(ui & 1) * 256 + tid] = st.w; } }
    __device__ __forceinline__ void operator()(const f32x4 (&acc)[2][2][4][2], const Unit& u, int wr, int wc, int fr, int fq, int ui = 0) const {
        const int r0 = wr * 64 + fr; const unsigned colb = (unsigned)((u.pn & 3) * 256 + wc * 32 + 8 * fq) * 2u;
        const PG8_LAS int* ld = lrow + (ui & 1) * 256; const PG8_LAS float* lw = (const PG8_LAS float*)(lrow + 512) + (ui & 1) * 256;
#pragma unroll
        for (int ai = 0; ai < 2; ++ai)
#pragma unroll
            for (int m = 0; m < 4; ++m) { const int r = r0 + ai * HALF + m * 16; const int d = ld[r]; const float wv = lw[r];
                if (d >= 0) {
#pragma unroll
                    for (int bj = 0; bj < 2; ++bj) { const f32x4 v0 = acc[ai][bj][m][0] * wv, v1 = acc[ai][bj][m][1] * wv;
                        u32x4 w; w.x = cvt_pk_bf16(v0[0], v0[1]); w.y = cvt_pk_bf16(v0[2], v0[3]); w.z = cvt_pk_bf16(v1[0], v1[1]); w.w = cvt_pk_bf16(v1[2], v1[3]);
                        *(u32x4*)((char*)Y + ((unsigned)d * 2048u + colb + (unsigned)(bj * HALF * 2))) = w; } } }
    }
};

struct DenseA { static constexpr bool GATHER = false; };
template <class Epi, class Sched, bool ALIGN_EPI = false, bool SP2 = false, class AOff = DenseA>
__device__ __forceinline__ void gemm_phase(PG8_LAS unsigned char* lds, const Gemm g, const Sched& S, const Epi& E, const AOff& AO = AOff()) {
    const int tid = threadIdx.x, wid = __builtin_amdgcn_readfirstlane(tid >> 6), lane = tid & 63, wr = wid >> 2, wc = wid & 3, fr = lane & 15, fq = lane >> 4;
    const int K = g.K, nt = K / BK;
    unsigned voffA[2], voffB[2]; int sR[2], sC[2];
#pragma unroll
    for (int i = 0; i < 2; ++i) { int R, C; stage_rc(tid * 16 + i * 8192, R, C); const int Rb = Epi::PERM ? ((R & ~31) + perm32(R & 31)) : R; sR[i] = R; sC[i] = C;
        voffA[i] = (unsigned)(R * K + C) * 2u; voffB[i] = (unsigned)(Rb * K + C) * 2u; }
    const size_t kstep = (size_t)(BK * 2);
    const size_t hstep = (size_t)HALF * K * 2;
    const size_t tstep = 2 * hstep;
    const unsigned ldsw = (unsigned)wid * 1024u;
    const int aoff = lds_byte(wr * 64 + fr, fq * 8), boff = lds_byte(wc * 32 + fr, fq * 8);
#define PG8_SA(b, h) (((b) * 2 + (h)) * HTB)
#define PG8_SB(b, h) ((4 + (b) * 2 + (h)) * HTB)
#define PG8_STAGE(bufoff, gbase, voff) do { _Pragma("unroll") for (int _i = 0; _i < 2; ++_i) \
        __builtin_amdgcn_global_load_lds((const unsigned*)((const char*)(gbase) + (voff)[_i]), (PG8_LAS unsigned*)(lds + (bufoff) + ldsw + _i * 8192), 16, 0, 0); } while (0)
#define PG8_LDA(dst, b, h) do { _Pragma("unroll") for (int m = 0; m < 4; ++m) _Pragma("unroll") for (int k = 0; k < 2; ++k) dst[m][k] = *(const PG8_LAS bf16x8*)(lds + PG8_SA(b, h) + aoff + m * 2048 + k * 1024); } while (0)
#define PG8_LDB(dst, b, h) do { _Pragma("unroll") for (int n = 0; n < 2; ++n) _Pragma("unroll") for (int k = 0; k < 2; ++k) dst[n][k] = *(const PG8_LAS bf16x8*)(lds + PG8_SB(b, h) + boff + n * 2048 + k * 1024); } while (0)
#define PG8_MMA(ai, bj, At, Bt) do { __builtin_amdgcn_s_setprio(1); _Pragma("unroll") for (int m = 0; m < 4; ++m) _Pragma("unroll") for (int n = 0; n < 2; ++n) _Pragma("unroll") for (int k = 0; k < 2; ++k) \
        acc[ai][bj][m][n] = __builtin_amdgcn_mfma_f32_16x16x32_bf16(Bt[n][k], At[m][k], acc[ai][bj][m][n], 0, 0, 0); __builtin_amdgcn_s_setprio(0); } while (0)
#define PG8_WAIT_V(n) asm volatile("s_waitcnt vmcnt(" #n ")" ::: "memory")
#define PG8_WAIT_L(n) asm volatile("s_waitcnt lgkmcnt(" #n ")" ::: "memory")
#define PG8_BAR __builtin_amdgcn_s_barrier()
#define PG8_SCHED __builtin_amdgcn_sched_barrier(0)
    Unit cur, nxt; int ui = 0;
    if (!S.next(0, cur)) return;
    f32x4 acc[2][2][4][2];
#pragma unroll
    for (int a = 0; a < 2; ++a)
#pragma unroll
        for (int b = 0; b < 2; ++b)
#pragma unroll
            for (int m = 0; m < 4; ++m)
#pragma unroll
                for (int n = 0; n < 2; ++n) acc[a][b][m][n] = (f32x4){0.f, 0.f, 0.f, 0.f};
    bf16x8 At[4][2], B0[2][2], B1[2][2];
    const char* cA = AOff::GATHER ? (const char*)g.A : (const char*)g.A + (size_t)cur.pm * tstep; const char* cB = (const char*)g.Bt + (size_t)cur.pn * tstep;
    unsigned c0[2], c1[2];
    c0[0] = voffA[0]; c0[1] = voffA[1]; c1[0] = voffA[0] + (unsigned)hstep; c1[1] = voffA[1] + (unsigned)hstep;
    unsigned cp0 = 0u, cp1 = 0u, np0 = 0u, np1 = 0u;
    const unsigned K2 = (unsigned)K * 2u, cb0 = (unsigned)sC[0] * 2u, cb1 = (unsigned)sC[1] * 2u;
    if constexpr (AOff::GATHER) { AO.get(cur, sR, cp0, cp1); np0 = cp0; np1 = cp1; }
#define PG8_AOFF(arr, pk, dense) unsigned arr[2]; if constexpr (AOff::GATHER) { arr[0] = ((pk) & 0xffffu) * K2 + cb0; arr[1] = ((pk) >> 16) * K2 + cb1; } else { arr[0] = dense[0]; arr[1] = dense[1]; }
    S.a_ready(cur);
    typename Epi::State est{}; E.prefetch(cur, est, tid);
    if constexpr (SP2) {
        PG8_STAGE(PG8_SB(0, 0), cB, voffB); PG8_STAGE(PG8_SB(0, 1), cB + hstep, voffB); { PG8_AOFF(q0, cp0, c0) PG8_AOFF(q1, cp1, c1) PG8_STAGE(PG8_SA(0, 0), cA, q0); PG8_STAGE(PG8_SA(0, 1), cA, q1); }
        if (wr == 1) PG8_BAR;
        PG8_WAIT_V(2); PG8_BAR;
        PG8_STAGE(PG8_SB(1, 0), cB + kstep, voffB); { PG8_AOFF(q0, cp0, c0) PG8_STAGE(PG8_SA(1, 0), cA + kstep, q0); } PG8_STAGE(PG8_SB(1, 1), cB + hstep + kstep, voffB);
        PG8_WAIT_V(6); PG8_BAR;
    } else {
        PG8_STAGE(PG8_SB(0, 0), cB, voffB); PG8_STAGE(PG8_SA(0, 0), cA, voffA); PG8_STAGE(PG8_SB(0, 1), cB + hstep, voffB); PG8_STAGE(PG8_SA(0, 1), cA + hstep, voffA);
        if (wr == 1) PG8_BAR;
        PG8_WAIT_V(4); PG8_BAR;
        PG8_STAGE(PG8_SB(1, 0), cB + kstep, voffB); PG8_STAGE(PG8_SA(1, 0), cA + kstep, voffA); PG8_STAGE(PG8_SB(1, 1), cB + hstep + kstep, voffB);
        PG8_WAIT_V(6); PG8_BAR;
    }
    for (;;) {
        E.stash(est, ui, tid);
        const bool has_next = S.next(ui + 1, nxt);
        const char* nA = AOff::GATHER ? cA : (has_next ? (const char*)g.A + (size_t)nxt.pm * tstep : cA); const char* nB = has_next ? (const char*)g.Bt + (size_t)nxt.pn * tstep : cB;
        if constexpr (AOff::GATHER) { if (has_next) AO.get(nxt, sR, np0, np1); else { np0 = cp0; np1 = cp1; } }
        for (int t = 0; t < nt; t += 2) {
            const bool last = (t == nt - 2);
            const char* a1 = cA + (size_t)(t + 1) * kstep;
            const char* a2 = last ? nA : cA + (size_t)(t + 2) * kstep; const char* b2 = last ? nB : cB + (size_t)(t + 2) * kstep;
            const char* a3 = a2 + kstep; const char* b3 = b2 + kstep;
            const unsigned sp0 = last ? np0 : cp0, sp1 = last ? np1 : cp1;
            if (last && has_next) S.a_ready(nxt);
            if constexpr (SP2) {
            PG8_LDB(B0, 0, 0); PG8_LDB(B1, 0, 1); PG8_SCHED; PG8_LDA(At, 0, 0); { PG8_AOFF(q1, cp1, c1) PG8_STAGE(PG8_SA(1, 1), a1, q1); }
            PG8_WAIT_V(8); PG8_WAIT_L(0); PG8_BAR; PG8_MMA(0, 0, At, B0); PG8_MMA(0, 1, At, B1); PG8_BAR; PG8_SCHED;
            PG8_LDA(At, 0, 1); PG8_STAGE(PG8_SB(0, 0), b2, voffB); PG8_STAGE(PG8_SB(0, 1), b2 + hstep, voffB); { PG8_AOFF(q0, sp0, c0) PG8_STAGE(PG8_SA(0, 0), a2, q0); }
            PG8_WAIT_V(8); PG8_WAIT_L(0); PG8_BAR; PG8_MMA(1, 0, At, B0); PG8_MMA(1, 1, At, B1); PG8_BAR; PG8_SCHED;
            PG8_LDB(B0, 1, 0); PG8_LDB(B1, 1, 1); PG8_SCHED; PG8_LDA(At, 1, 0); { PG8_AOFF(q1, sp1, c1) PG8_STAGE(PG8_SA(0, 1), a2, q1); }
            PG8_WAIT_V(8); PG8_WAIT_L(0); PG8_BAR; PG8_MMA(0, 0, At, B0); PG8_MMA(0, 1, At, B1); PG8_BAR; PG8_SCHED;
            PG8_LDA(At, 1, 1); PG8_STAGE(PG8_SB(1, 0), b3, voffB); PG8_STAGE(PG8_SB(1, 1), b3 + hstep, voffB); { PG8_AOFF(q0, sp0, c0) PG8_STAGE(PG8_SA(1, 0), a3, q0); }
            PG8_WAIT_V(8); PG8_WAIT_L(0); PG8_BAR; PG8_MMA(1, 0, At, B0); PG8_MMA(1, 1, At, B1); PG8_BAR; PG8_SCHED;
            } else {
            PG8_LDB(B0, 0, 0); PG8_SCHED; PG8_LDA(At, 0, 0); PG8_STAGE(PG8_SA(1, 1), a1 + hstep, voffA);
            PG8_WAIT_L(8); PG8_BAR; PG8_WAIT_L(0); PG8_MMA(0, 0, At, B0); PG8_BAR; PG8_SCHED;
            PG8_LDB(B1, 0, 1); PG8_STAGE(PG8_SB(0, 0), b2, voffB);
            PG8_BAR; PG8_WAIT_L(0); PG8_MMA(0, 1, At, B1); PG8_BAR;
            PG8_LDA(At, 0, 1); PG8_STAGE(PG8_SA(0, 0), a2, voffA);
            PG8_BAR; PG8_WAIT_L(0); PG8_MMA(1, 0, At, B0); PG8_BAR; PG8_SCHED;
            PG8_STAGE(PG8_SB(0, 1), b2 + hstep, voffB);
            PG8_WAIT_V(6); PG8_BAR; PG8_MMA(1, 1, At, B1); PG8_BAR;
            PG8_LDB(B0, 1, 0); PG8_SCHED; PG8_LDA(At, 1, 0); PG8_STAGE(PG8_SA(0, 1), a2 + hstep, voffA);
            PG8_WAIT_L(8); PG8_BAR; PG8_WAIT_L(0); PG8_MMA(0, 0, At, B0); PG8_BAR; PG8_SCHED;
            PG8_LDB(B1, 1, 1); PG8_STAGE(PG8_SB(1, 0), b3, voffB);
            PG8_BAR; PG8_WAIT_L(0); PG8_MMA(0, 1, At, B1); PG8_BAR;
            PG8_LDA(At, 1, 1); PG8_STAGE(PG8_SA(1, 0), a3, voffA);
            PG8_BAR; PG8_WAIT_L(0); PG8_MMA(1, 0, At, B0); PG8_BAR; PG8_SCHED;
            PG8_STAGE(PG8_SB(1, 1), b3 + hstep, voffB);
            PG8_WAIT_V(6); PG8_BAR; PG8_MMA(1, 1, At, B1); PG8_BAR;
            }
        }
        if constexpr (ALIGN_EPI) { if (wr == 0) PG8_BAR; }
        if constexpr (!Epi::AFTER_DRAIN) { E(acc, cur, wr, wc, fr, fq, ui); S.done(cur); if (has_next) E.prefetch(nxt, est, tid); }
        if (!has_next) break;
#pragma unroll
        for (int a = 0; a < 2; ++a)
#pragma unroll
            for (int b = 0; b < 2; ++b)
#pragma unroll
                for (int m = 0; m < 4; ++m)
#pragma unroll
                    for (int n = 0; n < 2; ++n) acc[a][b][m][n] = (f32x4){0.f, 0.f, 0.f, 0.f};
        cur = nxt; cA = nA; cB = nB; ++ui;
        if constexpr (AOff::GATHER) { cp0 = np0; cp1 = np1; }
        if constexpr (ALIGN_EPI) { if (wr == 1) PG8_BAR; }
    }
    PG8_WAIT_V(0);
    if constexpr (!ALIGN_EPI) { if (wr == 0) PG8_BAR; }
    PG8_BAR;
    if constexpr (Epi::AFTER_DRAIN) { E.fused(acc, cur, wr, wc, fr, fq, lds, wid, lane); S.done(cur); }
#undef PG8_SA
#undef PG8_SB
#undef PG8_STAGE
#undef PG8_LDA
#undef PG8_LDB
#undef PG8_MMA
#undef PG8_WAIT_V
#undef PG8_WAIT_L
#undef PG8_BAR
#undef PG8_SCHED
#undef PG8_AOFF
}
}
namespace attn_body {
using bf16=__hip_bfloat16;
using bf16x8=__attribute__((ext_vector_type(8)))short;
using s16x4=__attribute__((ext_vector_type(4)))short;
using f32x16=__attribute__((ext_vector_type(16)))float;
using u32x4=__attribute__((ext_vector_type(4)))unsigned;
constexpr int D=64;
constexpr int NW=8,QBLK=32,QB=QBLK*NW,KVBLK=64;
__device__ __forceinline__ int crow(int r,int hi){return (r&3)+8*(r>>2)+4*hi;}
#define SBAR() __builtin_amdgcn_sched_barrier(0)
__device__ __forceinline__ void cmask(f32x16&p0,f32x16&p1,int jb,int qrel,int hi){
  const float NEG=-INFINITY; int kb=64*jb+4*hi;
  #pragma unroll
  for(int r=0;r<16;++r){int kv=kb+(r&3)+8*(r>>2); if(kv>qrel)p0[r]=NEG; if(kv+32>qrel)p1[r]=NEG;}
}

constexpr int NSLOT=3, SLOTB=8192;
constexpr int LDS_K=0, LDS_V=NSLOT*SLOTB, LDS_WS=2*NSLOT*SLOTB, LDS_OST=LDS_WS+NW*64*4, LDS_BYTES=LDS_OST+NW*4096;
constexpr float C2=0.125f*1.4426950408889634f;
__device__ __forceinline__ void glds16(const void*gsrc,unsigned lds_dst){unsigned keep;
  asm volatile("s_mov_b32 %0, m0\n\ts_mov_b32 m0, %2\n\ts_nop 0\n\tglobal_load_lds_dwordx4 %1, off\n\ts_mov_b32 m0, %0":"=&s"(keep):"v"(gsrc),"s"(lds_dst):"memory");}
__device__ __forceinline__ float max3f(float a,float b,float c){float r;asm("v_max3_f32 %0, %1, %2, %3":"=v"(r):"v"(a),"v"(b),"v"(c));return r;}
__device__ __forceinline__ float max2f(float a,float b){float r;asm("v_max_f32_e32 %0, %1, %2":"=v"(r):"v"(a),"v"(b));return r;}
__device__ __forceinline__ float fadd_s(float a,float b){float r;asm("v_add_f32_e32 %0, %1, %2":"=v"(r):"v"(a),"v"(b));return r;}
__device__ __forceinline__ float fsub_s(float a,float b){float r;asm("v_sub_f32_e32 %0, %1, %2":"=v"(r):"v"(a),"v"(b));return r;}
typedef float f32x2_t __attribute__((ext_vector_type(2))); typedef __bf16 bf16x2_t __attribute__((ext_vector_type(2)));
__device__ __forceinline__ unsigned cvtpk_s(float lo,float hi){f32x2_t v={lo,hi};bf16x2_t b=__builtin_convertvector(v,bf16x2_t);return __builtin_bit_cast(unsigned,b);}
#define WAIT_BAR(N) asm volatile("s_waitcnt vmcnt(" #N ") lgkmcnt(0)\n\ts_barrier":::"memory")

__device__ __forceinline__ void qkt(f32x16&p0,f32x16&p1,const char*Kslot,const bf16x8*qr,const f32x16&negm,int r32,int hi){
  const char*kb=Kslot+hi*1024+r32*16;
  #pragma unroll
  for(int d0=0;d0<4;++d0){
    const bf16x8 b0=*reinterpret_cast<const bf16x8*>(kb+d0*2048);
    const bf16x8 b1=*reinterpret_cast<const bf16x8*>(kb+d0*2048+512);
    if(d0==0){p0=__builtin_amdgcn_mfma_f32_32x32x16_bf16(b0,qr[0],negm,0,0,0);p1=__builtin_amdgcn_mfma_f32_32x32x16_bf16(b1,qr[0],negm,0,0,0);}
    else{p0=__builtin_amdgcn_mfma_f32_32x32x16_bf16(b0,qr[d0],p0,0,0,0);p1=__builtin_amdgcn_mfma_f32_32x32x16_bf16(b1,qr[d0],p1,0,0,0);}}
}
typedef __attribute__((address_space(3))) const char* lds_cptr;
typedef short v4i16_t __attribute__((ext_vector_type(4)));
__device__ __forceinline__ void kload8(bf16x8*kf,lds_cptr kp){
  kf[0]=*(const __attribute__((address_space(3))) bf16x8*)(kp);      kf[1]=*(const __attribute__((address_space(3))) bf16x8*)(kp+512);
  kf[2]=*(const __attribute__((address_space(3))) bf16x8*)(kp+2048); kf[3]=*(const __attribute__((address_space(3))) bf16x8*)(kp+2560);
  kf[4]=*(const __attribute__((address_space(3))) bf16x8*)(kp+4096); kf[5]=*(const __attribute__((address_space(3))) bf16x8*)(kp+4608);
  kf[6]=*(const __attribute__((address_space(3))) bf16x8*)(kp+6144); kf[7]=*(const __attribute__((address_space(3))) bf16x8*)(kp+6656);
}
__device__ __forceinline__ void kload2(bf16x8*kf,lds_cptr kp,int j){ kf[2*j]=*(const __attribute__((address_space(3))) bf16x8*)(kp+j*2048); kf[2*j+1]=*(const __attribute__((address_space(3))) bf16x8*)(kp+j*2048+512); }
__device__ __forceinline__ s16x4 vtr(lds_cptr p){ return __builtin_bit_cast(s16x4,__builtin_amdgcn_ds_read_tr16_b64_v4i16((__attribute__((address_space(3))) v4i16_t*)p)); }
__device__ __forceinline__ float rowmax(const f32x16&p0,const f32x16&p1){
  float a=max3f(p0[0],p0[1],p1[0]),b=max3f(p0[2],p0[3],p1[1]);a=max3f(a,p1[2],p1[3]);
  #pragma unroll
  for(int r=4;r<16;r+=4){a=max3f(a,p0[r],p0[r+1]);b=max3f(b,p0[r+2],p0[r+3]);a=max3f(a,p1[r],p1[r+1]);b=max3f(b,p1[r+2],p1[r+3]);}
  const float m=max2f(a,b);
  auto rr=__builtin_amdgcn_permlane32_swap(__float_as_uint(m),__float_as_uint(m),false,false);
  return max2f(__uint_as_float(rr[0]),__uint_as_float(rr[1]));
}
__device__ __forceinline__ void pv(f32x16*o,int vb,bf16x8 pa0,bf16x8 pa1,bf16x8 pa2,bf16x8 pa3){
  #pragma unroll
  for(int d0=0;d0<2;++d0){s16x4 lo[4],hi[4];
    #pragma unroll
    for(int ks=0;ks<4;++ks){
      asm volatile("ds_read_b64_tr_b16 %0,%1 offset:%c2":"=&v"(lo[ks]):"v"(vb),"i"(d0*4096+ks*1024):"memory");
      asm volatile("ds_read_b64_tr_b16 %0,%1 offset:%c2":"=&v"(hi[ks]):"v"(vb),"i"(d0*4096+ks*1024+512):"memory");}
    asm volatile("s_waitcnt lgkmcnt(0)":::"memory");SBAR();
    #define PK(k) (bf16x8){lo[k][0],lo[k][1],lo[k][2],lo[k][3],hi[k][0],hi[k][1],hi[k][2],hi[k][3]}
    o[d0]=__builtin_amdgcn_mfma_f32_32x32x16_bf16(pa0,PK(0),o[d0],0,0,0);
    o[d0]=__builtin_amdgcn_mfma_f32_32x32x16_bf16(pa1,PK(1),o[d0],0,0,0);
    o[d0]=__builtin_amdgcn_mfma_f32_32x32x16_bf16(pa2,PK(2),o[d0],0,0,0);
    o[d0]=__builtin_amdgcn_mfma_f32_32x32x16_bf16(pa3,PK(3),o[d0],0,0,0);
    #undef PK
  }
}

#ifndef ATTN_STORE16
#define ATTN_STORE16(p,v) (*(u32x4*)(p)=(v))
#endif
template<int THRL,int QP,int KP,int VP,int OP,class Hook> __device__ __forceinline__ void attn_unit(const bf16*Qw0,const bf16*__restrict__ Kh,const bf16*__restrict__ Vh,bf16*Ow0,const int NT,const Hook&hk,char*shm){
  const int tid=threadIdx.x,lane=tid&63,r32=lane&31,hi=lane>>5; const int wid=__builtin_amdgcn_readfirstlane(tid>>6);
  const bf16*Qw=Qw0+(long)(wid*QBLK)*QP;
#if defined(PROBE_SUB)
  #define ASTAMP(i) do{ if(Hook::MASK && hk.tsp && blockIdx.x==0 && tid==0) hk.tsp[(i)]=__builtin_amdgcn_s_memrealtime(); }while(0)
#else
  #define ASTAMP(i) do{}while(0)
#endif
  ASTAMP(0);
  const unsigned lds0=(unsigned)(uintptr_t)shm;
  float*wsf=(float*)(shm+LDS_WS)+wid*64;
  const bf16*ksrc=Kh+(long)lane*KP+wid*8;
  const bf16*vsrc=Vh+(long)(16*(wid&3)+(lane>>2))*VP+(wid>>2)*32+(lane&3)*8;
  const unsigned kdst=lds0+LDS_K+wid*1024, vdst=lds0+LDS_V+wid*1024;
  #define DMA_K(t,slot) glds16(ksrc+(long)hk.tile_row(t)*KP,(unsigned)__builtin_amdgcn_readfirstlane(kdst+(slot)))
  #define DMA_V(t,slot) glds16(vsrc+(long)hk.tile_row(t)*VP,(unsigned)__builtin_amdgcn_readfirstlane(vdst+(slot)))
  const int vb0=(int)(lds0+LDS_V)+((lane>>4)&1)*32+(lane&3)*8+(4*hi+((lane&15)>>2))*64;
  const char*Kbase=shm+LDS_K; bf16x8 kf[8];
  const lds_cptr shm3=(lds_cptr)shm; const lds_cptr kp0=shm3+LDS_K+hi*1024+r32*16; const lds_cptr vp0=shm3+LDS_V+((lane>>4)&1)*32+(lane&3)*8+(4*hi+((lane&15)>>2))*64;
  DMA_K(0,0);DMA_V(0,0);DMA_K(1,SLOTB);
  bf16x8 qr[4];
  #pragma unroll
  for(int d0=0;d0<4;++d0)qr[d0]=*reinterpret_cast<const bf16x8*>(&Qw[(long)r32*QP+d0*16+hi*8]);
  float mhat=0.f,l_reg=0.f;f32x16 o[2];o[0]=f32x16{};o[1]=f32x16{};f32x16 negm=f32x16{};if(Hook::NEGC)asm volatile("":"+v"(negm)); const f32x16 zc=f32x16{};
  #define CMASK(P0,P1,t) do{ if(Hook::MASK) hk.mask(P0,P1,(t),mhat); }while(0)
  bool resc=false;
  #define START(P0,P1) do{ const float rm=rowmax(P0,P1); resc=false; \
    { const float dl=rm; mhat=fadd_s(mhat,dl); \
      _Pragma("unroll") for(int r=0;r<16;++r){P0[r]=fsub_s(P0[r],dl);P1[r]=fsub_s(P1[r],dl);} \
      if(Hook::NEGC){ _Pragma("unroll") for(int r=0;r<16;++r)negm[r]=-mhat; asm volatile("":"+v"(negm)); } } \
    _Pragma("unroll") for(int r=0;r<16;++r)P0[r]=__builtin_amdgcn_exp2f(P0[r]); }while(0)
  #define RESC() do{ if(resc){ asm volatile("s_waitcnt lgkmcnt(0)":::"memory"); \
      _Pragma("unroll") for(int d_=0;d_<2;++d_) _Pragma("unroll") for(int r=0;r<16;++r)o[d_][r]*=wsf[crow(r,hi)]; } }while(0)
  f32x16 pA0,pA1,pB0,pB1;
  int sl_prev=0,sl_cur=0,sl_next=SLOTB;
  #define ROT() do{sl_prev=sl_cur;sl_cur=sl_next;sl_next=(sl_next==(NSLOT-1)*SLOTB)?0:sl_next+SLOTB;}while(0)
  DMA_K(2,2*SLOTB);
  WAIT_BAR(3); ASTAMP(1);
  qkt(pA0,pA1,Kbase,qr,(Hook::NEGC?negm:zc),r32,hi);asm volatile("s_nop 15\n\ts_nop 7":"+v"(pA0),"+v"(pA1));CMASK(pA0,pA1,0);
  START(pA0,pA1);
  _Pragma("unroll") for(int r=0;r<16;++r)pA1[r]=__builtin_amdgcn_exp2f(pA1[r]);
  WAIT_BAR(0);
  DMA_K(3,0);DMA_V(1,SLOTB);
  ROT();
  kload8(kf,kp0+sl_cur);
  WAIT_BAR(2); ASTAMP(2);
  s16x4 vlo[8],vhi[8]; u32x4 pw0,pw1,pw2,pw3;
  #define PKW(P,B) cvtpk_s(P[B],P[B+1])
  #define PAF(k) __builtin_bit_cast(bf16x8,pw##k)
  #define VFR(i) (bf16x8){vlo[i][0],vlo[i][1],vlo[i][2],vlo[i][3],vhi[i][0],vhi[i][1],vhi[i][2],vhi[i][3]}
  #define PIN(x) asm volatile("":"+v"(x))
  #define MX3(a,b,c) __builtin_fmaxf(__builtin_fmaxf((a),(b)),(c))
  #define GAPA(MF,A0,A1,A2,A3,W0,W1,PW) do{ MF; sacc+=A0; sacc+=A1; sacc+=A2; sacc+=A3; PIN(sacc); W0; W1; PIN(PW); SBAR(); }while(0)
  #define EX(v) __builtin_amdgcn_exp2f(v)
  #define GAPB(MF,X,B) do{ MF; X[B]=EX(X[B]); X[B+1]=EX(X[B+1]); X[B+2]=EX(X[B+2]); X[B+3]=EX(X[B+3]); PIN(X); SBAR(); }while(0)
  #define VRD(i) do{ vlo[i]=vtr(vp_+(((i)>>2)*4096+((i)&3)*1024)); vhi[i]=vtr(vp_+(((i)>>2)*4096+((i)&3)*1024+512)); }while(0)
  #define KRD(G,j) do{ if(G){ kload2(kf,kp0+sl_next,j); SBAR(); } }while(0)
  #define STEP(C0,C1,P0,P1,t,GK,GV,GL) do{ SBAR(); \
    const lds_cptr vp_=vp0+sl_prev; \
    VRD(0); SBAR(); float sacc=(P0[0]+P0[1]); \
    GAPA(C0=__builtin_amdgcn_mfma_f32_32x32x16_bf16(kf[0],qr[0],(Hook::NEGC?negm:zc),0,0,0), P0[2],P0[3],P0[4],P0[5],     pw0[0]=PKW(P0,0), pw0[1]=PKW(P0,2), pw0); \
    VRD(4); SBAR(); GAPA(C1=__builtin_amdgcn_mfma_f32_32x32x16_bf16(kf[1],qr[0],(Hook::NEGC?negm:zc),0,0,0), P0[6],P0[7],P0[8],P0[9],     pw0[2]=PKW(P0,4), pw0[3]=PKW(P0,6), pw0); \
    VRD(1); SBAR(); GAPA(C0=__builtin_amdgcn_mfma_f32_32x32x16_bf16(kf[2],qr[1],C0,0,0,0),   P0[10],P0[11],P0[12],P0[13], pw1[0]=PKW(P0,8), pw1[1]=PKW(P0,10), pw1); \
    VRD(5); SBAR(); GAPA(C1=__builtin_amdgcn_mfma_f32_32x32x16_bf16(kf[3],qr[1],C1,0,0,0),   P0[14],P0[15],P1[0],P1[1],   pw1[2]=PKW(P0,12),pw1[3]=PKW(P0,14), pw1); \
    VRD(2); SBAR(); GAPA(C0=__builtin_amdgcn_mfma_f32_32x32x16_bf16(kf[4],qr[2],C0,0,0,0),   P1[2],P1[3],P1[4],P1[5],     pw2[0]=PKW(P1,0), pw2[1]=PKW(P1,2), pw2); \
    VRD(6); SBAR(); GAPA(C1=__builtin_amdgcn_mfma_f32_32x32x16_bf16(kf[5],qr[2],C1,0,0,0),   P1[6],P1[7],P1[8],P1[9],     pw2[2]=PKW(P1,4), pw2[3]=PKW(P1,6), pw2); \
    VRD(3); SBAR(); GAPA(C0=__builtin_amdgcn_mfma_f32_32x32x16_bf16(kf[6],qr[3],C0,0,0,0),   P1[10],P1[11],P1[12],P1[13], pw3[0]=PKW(P1,8), pw3[1]=PKW(P1,10), pw3); \
    VRD(7); SBAR(); GAPA(C1=__builtin_amdgcn_mfma_f32_32x32x16_bf16(kf[7],qr[3],C1,0,0,0),   P1[14],P1[15],0.f,0.f,       pw3[2]=PKW(P1,12),pw3[3]=PKW(P1,14), pw3); \
    l_reg+=sacc; \
    if(GK){DMA_K((t)+3,sl_cur);} if(GV){DMA_V((t)+1,sl_next);} \
    CMASK(C0,C1,t); \
    { float a=MX3(C0[0],C0[1],C1[0]),b=MX3(C0[2],C0[3],C1[1]); a=MX3(a,C1[2],C1[3]); \
      _Pragma("unroll") for(int r=4;r<16;r+=4){a=MX3(a,C0[r],C0[r+1]);b=MX3(b,C0[r+2],C0[r+3]);a=MX3(a,C1[r],C1[r+1]);b=MX3(b,C1[r+2],C1[r+3]);} \
      float rm=__builtin_fmaxf(a,b); { auto rr=__builtin_amdgcn_permlane32_swap(__float_as_uint(rm),__float_as_uint(rm),false,false); rm=__builtin_fmaxf(__uint_as_float(rr[0]),__uint_as_float(rr[1])); } \
      resc=false; \
      if(__builtin_expect(__any(rm>(float)THRL),0)){ const float dl=__builtin_fmaxf(rm,0.f); mhat+=dl; \
        _Pragma("unroll") for(int r=0;r<16;++r){C0[r]-=dl;C1[r]-=dl;} \
        if(Hook::NEGC){ _Pragma("unroll") for(int r=0;r<16;++r)negm[r]=-mhat; asm volatile("":"+v"(negm)); } \
        const float f=__builtin_amdgcn_exp2f(-dl); l_reg*=f; if(hi==0)wsf[r32]=f; resc=true; } } \
    SBAR(); \
    GAPB(o[0]=__builtin_amdgcn_mfma_f32_32x32x16_bf16(PAF(0),VFR(0),o[0],0,0,0), C0,0); \
    GAPB(o[1]=__builtin_amdgcn_mfma_f32_32x32x16_bf16(PAF(0),VFR(4),o[1],0,0,0), C0,4); \
    KRD(GL,0); GAPB(o[0]=__builtin_amdgcn_mfma_f32_32x32x16_bf16(PAF(1),VFR(1),o[0],0,0,0), C0,8); \
    KRD(GL,1); GAPB(o[1]=__builtin_amdgcn_mfma_f32_32x32x16_bf16(PAF(1),VFR(5),o[1],0,0,0), C0,12); \
    KRD(GL,2); GAPB(o[0]=__builtin_amdgcn_mfma_f32_32x32x16_bf16(PAF(2),VFR(2),o[0],0,0,0), C1,0); \
    KRD(GL,3); GAPB(o[1]=__builtin_amdgcn_mfma_f32_32x32x16_bf16(PAF(2),VFR(6),o[1],0,0,0), C1,4); \
    GAPB(o[0]=__builtin_amdgcn_mfma_f32_32x32x16_bf16(PAF(3),VFR(3),o[0],0,0,0), C1,8); \
    GAPB(o[1]=__builtin_amdgcn_mfma_f32_32x32x16_bf16(PAF(3),VFR(7),o[1],0,0,0), C1,12); \
    }while(0)
  int t=1;
  #undef CMASK
  #define CMASK(P0,P1,t) do{ if(Hook::MASK) hk.mask(P0,P1,(t),mhat); }while(0)
  for(;t+5<NT;t+=2){
    STEP(pB0,pB1,pA0,pA1,t,true,true,true);     WAIT_BAR(2); RESC(); ROT();
    STEP(pA0,pA1,pB0,pB1,t+1,true,true,true);   WAIT_BAR(2); RESC(); ROT();
  }
  #undef CMASK
  #define CMASK(P0,P1,t) do{ if(Hook::MASK) hk.mask(P0,P1,(t),mhat); }while(0)
  #define ENDW(tt) do{ if((tt)+3<NT){WAIT_BAR(2);} else if((tt)+2<NT){WAIT_BAR(1);} else {WAIT_BAR(0);} }while(0)
  for(;t+1<NT;t+=2){
    STEP(pB0,pB1,pA0,pA1,t,(t+3<NT),(t+1<NT),(t+1<NT));       ENDW(t);   RESC(); ROT();
    STEP(pA0,pA1,pB0,pB1,t+1,(t+4<NT),(t+2<NT),(t+2<NT));     ENDW(t+1); RESC(); ROT();
  }
  ASTAMP(3);
  STEP(pB0,pB1,pA0,pA1,NT-1,false,false,false); RESC();
  ASTAMP(4);
  { float sacc=pB0[0]+pB0[1]; _Pragma("unroll") for(int r=2;r<16;++r)sacc+=pB0[r]; _Pragma("unroll") for(int r=0;r<16;++r)sacc+=pB1[r]; l_reg+=sacc;
    pw0=(u32x4){PKW(pB0,0),PKW(pB0,2),PKW(pB0,4),PKW(pB0,6)};pw1=(u32x4){PKW(pB0,8),PKW(pB0,10),PKW(pB0,12),PKW(pB0,14)};pw2=(u32x4){PKW(pB1,0),PKW(pB1,2),PKW(pB1,4),PKW(pB1,6)};pw3=(u32x4){PKW(pB1,8),PKW(pB1,10),PKW(pB1,12),PKW(pB1,14)};
    SBAR(); pv(o,vb0+sl_cur,PAF(0),PAF(1),PAF(2),PAF(3)); }
  #undef PKW
  #undef PAF
  #undef VFR
  #undef PIN
  #undef MX3
  #undef GAPA
  #undef GAPB
  #undef EX
  #undef VRD
  #undef KRD
  #undef STEP
  #undef ENDW
  ASTAMP(5);
  {auto rr=__builtin_amdgcn_permlane32_swap(__float_as_uint(l_reg),__float_as_uint(l_reg),false,false);l_reg=__uint_as_float(rr[0])+__uint_as_float(rr[1]);}
  if(hi==0)wsf[32+r32]=l_reg;asm volatile("s_waitcnt lgkmcnt(0)":::"memory");
  float rli[16];
  #pragma unroll
  for(int r=0;r<16;++r)rli[r]=__builtin_amdgcn_rcpf(wsf[32+crow(r,hi)]);
  bf16*Ow=Ow0+(long)(wid*QBLK)*OP;
  { bf16*stg=(bf16*)(shm+LDS_OST)+wid*2048;
    #pragma unroll
    for(int r=0;r<16;++r){const int orow=crow(r,hi);
      #pragma unroll
      for(int d0=0;d0<2;++d0)stg[orow*64+d0*32+r32]=__float2bfloat16(o[d0][r]*rli[r]);}
    asm volatile("s_waitcnt lgkmcnt(0)":::"memory");
    #pragma unroll
    for(int i=0;i<4;++i){const int row=i*8+(lane>>3),ch=lane&7; const u32x4 v=*(const u32x4*)(stg+row*64+ch*8); ATTN_STORE16(Ow+(long)row*OP+ch*8,v);} }
  ASTAMP(6);
  asm volatile("s_waitcnt lgkmcnt(0)\n\ts_barrier":::"memory"); ASTAMP(7);
  #undef ASTAMP
  #undef DMA_K
  #undef DMA_V
  #undef CMASK
  #undef START
  #undef RESC
  #undef ROT
}
constexpr int ATTN_LDS_BYTES=LDS_BYTES;
#undef SBAR
#undef WAIT_BAR
}
#define GAS __attribute__((address_space(1)))
#define LAS __attribute__((address_space(3)))
typedef unsigned short bf16;
typedef unsigned v4u __attribute__((ext_vector_type(4)));
typedef unsigned v2u __attribute__((ext_vector_type(2)));
typedef float f32x4 __attribute__((ext_vector_type(4)));
typedef float f32x2 __attribute__((ext_vector_type(2)));
#define LDS_WAIT() asm volatile("s_waitcnt lgkmcnt(0)" ::: "memory")

constexpr int NWAVES = 8;
constexpr int NB = 8, SEQ = 4096, DM = 1024, LC = 256, TB = SEQ + LC, TT = NB * TB, TX = NB * SEQ;
constexpr int NE = 32, MAXSLOT = 77824;
constexpr float EPS = 1e-6f;
constexpr float LOG2E = 1.4426950408889634f;
constexpr float C2 = 0.125f * LOG2E;
constexpr size_t MiB = 1u << 20;
constexpr size_t WS_CTL = 0, CTL_ZERO_BYTES = 1 * MiB;
constexpr size_t WS_MOD = 1 * MiB;
constexpr size_t WS_ROPE = 2 * MiB;
constexpr size_t WS_WTR = 2 * MiB + 65536;
constexpr size_t WS_TOK = 3 * MiB;
constexpr size_t WS_SLOT = 4 * MiB;
constexpr size_t WS_CTX = 5 * MiB;
constexpr size_t WS_WINE = 13 * MiB, WS_WOUTE = 16 * MiB, WS_WINO = 18 * MiB, WS_WOUTO = 24 * MiB, WS_W13 = 26 * MiB, WS_W2 = 154 * MiB;
constexpr size_t WS_HA = 218 * MiB;
constexpr size_t WS_R1 = 286 * MiB;
constexpr size_t R1_QE = 0, R1_KE = 34 * MiB, R1_VE = 43 * MiB, R1_UE = 52 * MiB;
constexpr size_t R1_QO = 0, R1_QKV_STRIDE = 68 * MiB;
constexpr size_t R1_YB = 0;
constexpr size_t R1_HMID = 136 * MiB, R1_Y2 = 0;
constexpr size_t WS_LOG = 498 * MiB;
constexpr size_t WS_ELIST = 503 * MiB;
constexpr size_t WS_XR = 512 * MiB;
constexpr size_t WS_END = 580 * MiB;
constexpr int LDS_BYTES = 163840, MISC_OFF = 147456;
constexpr int NA_TAB_OFF = 90112;

struct Args { const float* in[25]; float* out; unsigned char* ws; int ph_lo, ph_hi; };

__device__ __forceinline__ unsigned f2bf(float f) { unsigned u = __builtin_bit_cast(unsigned, f); return (u + 0x7fffu + ((u >> 16) & 1u)) >> 16; }
__device__ __forceinline__ unsigned pk2(float lo, float hi) { unsigned r; asm("v_cvt_pk_bf16_f32 %0, %1, %2" : "=v"(r) : "v"(lo), "v"(hi)); return r; }
__device__ __forceinline__ float bf2f(unsigned short h) { return __builtin_bit_cast(float, (unsigned)h << 16); }
__device__ __forceinline__ float bflo(unsigned w) { return __builtin_bit_cast(float, w << 16); }
__device__ __forceinline__ float bfhi(unsigned w) { return __builtin_bit_cast(float, w & 0xffff0000u); }
__device__ __forceinline__ float wave_sum(float v) {
#pragma unroll
    for (int o = 1; o < 64; o <<= 1) v += __shfl_xor(v, o);
    return v;
}

__device__ __forceinline__ Args fetch_args() {
    const __attribute__((address_space(4))) Args* p = (const __attribute__((address_space(4))) Args*)__builtin_amdgcn_kernarg_segment_ptr();
    asm volatile("" : "+s"(p));
    Args r;
#pragma unroll
    for (int i = 0; i < 25; ++i) r.in[i] = p->in[i];
    r.out = p->out; r.ws = p->ws; r.ph_lo = p->ph_lo; r.ph_hi = p->ph_hi;
    return r;
}
constexpr int NPH = 19;
__device__ __forceinline__ void mod_item(const Args& a, int l, int n0, int lane) {
    const float* W = a.in[4] + (size_t)l * 1024 * 6144 + n0;
    float acc[9][8];
#pragma unroll
    for (int r = 0; r < 9; ++r)
#pragma unroll
        for (int q = 0; q < 8; ++q) acc[r][q] = 0.f;
#pragma unroll 4
    for (int i = 0; i < 16; ++i) { const int k = lane + 64 * i; const f32x4 w0 = *(const f32x4*)(W + (size_t)k * 6144), w1 = *(const f32x4*)(W + (size_t)k * 6144 + 4);
#pragma unroll
        for (int r = 0; r < 9; ++r) { const float cv = (r < 8) ? a.in[1][r * 1024 + k] : a.in[3][k]; const float sv = cv / (1.0f + expf(-cv));
            acc[r][0] += sv * w0.x; acc[r][1] += sv * w0.y; acc[r][2] += sv * w0.z; acc[r][3] += sv * w0.w; acc[r][4] += sv * w1.x; acc[r][5] += sv * w1.y; acc[r][6] += sv * w1.z; acc[r][7] += sv * w1.w; } }
#define MTR(ARR, N, MASK) do { const bool hib = (lane & (MASK)) != 0; _Pragma("unroll") for (int jj = 0; jj < (N) / 2; ++jj) { \
        const float send = hib ? ARR[jj] : ARR[jj + (N) / 2]; const float recv = __shfl_xor(send, (MASK)); const float keep = hib ? ARR[jj + (N) / 2] : ARR[jj]; ARR[jj] = keep + recv; } } while (0)
    float v64[64], v8[8];
#pragma unroll
    for (int r = 0; r < 8; ++r)
#pragma unroll
        for (int q = 0; q < 8; ++q) v64[r * 8 + q] = acc[r][q];
#pragma unroll
    for (int q = 0; q < 8; ++q) v8[q] = acc[8][q];
    MTR(v64, 64, 32); MTR(v64, 32, 16); MTR(v64, 16, 8); MTR(v64, 8, 4); MTR(v64, 4, 2); MTR(v64, 2, 1);
    MTR(v8, 8, 32); MTR(v8, 4, 16); MTR(v8, 2, 8);
    float s8 = v8[0]; s8 += __shfl_xor(s8, 4); s8 += __shfl_xor(s8, 2); s8 += __shfl_xor(s8, 1);
#undef MTR
    { const int r = lane >> 3, q = lane & 7; ((float*)(a.ws + WS_MOD))[(size_t)(l * 9 + r) * 6144 + n0 + q] = v64[0] + a.in[5][l * 6144 + n0 + q]; }
    if ((lane & 7) == 0) { const int q = lane >> 3; ((float*)(a.ws + WS_MOD))[(size_t)(l * 9 + 8) * 6144 + n0 + q] = s8 + a.in[5][l * 6144 + n0 + q]; }
}
__device__ __forceinline__ void weff_item(const Args& a, int item, int lane, LAS float* scr) {
    const int g = item >> 8, nb = (item >> 4) & 15, cb = item & 15; const int n = nb * 64 + lane, c0 = cb * 8;
    const float* wo = a.in[9] + (size_t)(512 + g * 128) * 1024 + n; const float* ps = a.in[13] + g * 128; const float* pw = a.in[12] + (size_t)(g * 128 + c0) * 128;
#pragma unroll
    for (int i = 0; i < 16; ++i) { const int idx = lane + 64 * i; scr[idx] = pw[idx] * ps[idx & 127]; }
    LDS_WAIT(); asm volatile("" ::: "memory");
    float acc[8];
#pragma unroll
    for (int c = 0; c < 8; ++c) acc[c] = 0.f;
#pragma unroll 8
    for (int d4 = 0; d4 < 32; ++d4) { float wv[4];
#pragma unroll
        for (int q = 0; q < 4; ++q) wv[q] = wo[(size_t)(4 * d4 + q) * 1024];
#pragma unroll
        for (int c = 0; c < 8; ++c) { const f32x4 p = *(const LAS f32x4*)(scr + c * 128 + 4 * d4); acc[c] += (p.x * wv[0] + p.y * wv[1]) + (p.z * wv[2] + p.w * wv[3]); } }
    LDS_WAIT(); asm volatile("" ::: "memory");
    v4u o; o.x = pk2(acc[0], acc[1]); o.y = pk2(acc[2], acc[3]); o.z = pk2(acc[4], acc[5]); o.w = pk2(acc[6], acc[7]);
    *(v4u*)((bf16*)(a.ws + WS_WOUTE) + (size_t)n * 1024 + 512 + g * 128 + c0) = o;
}
__device__ __forceinline__ void weff_block(const Args& a, int item, LAS unsigned char* lds, int tid) {
    const int g = item >> 4, n0 = (item & 15) * 64;
    LAS float* At = (LAS float*)lds; LAS float* Bs = At + 128 * 132;
    const float* pw = a.in[12] + (size_t)g * 128 * 128; const float* ps = a.in[13] + g * 128; const float* wo = a.in[9] + (size_t)(512 + g * 128) * 1024 + n0;
#pragma unroll 8
    for (int i = 0; i < 32; ++i) { const int idx = tid + 512 * i, c = idx >> 7, d = idx & 127; At[d * 132 + c] = pw[idx] * ps[d]; }
#pragma unroll 8
    for (int i = 0; i < 16; ++i) { const int idx = tid + 512 * i, d = idx >> 6, n = idx & 63; Bs[idx] = wo[(size_t)d * 1024 + n]; }
    __syncthreads();
    const int n = tid & 63, cg = tid >> 6;
    float acc[16];
#pragma unroll
    for (int i = 0; i < 16; ++i) acc[i] = 0.f;
#pragma unroll 4
    for (int d = 0; d < 128; ++d) { const float b = Bs[d * 64 + n];
#pragma unroll
        for (int q = 0; q < 4; ++q) { const f32x4 av = *(const LAS f32x4*)(At + d * 132 + 16 * cg + 4 * q); acc[4 * q] += av.x * b; acc[4 * q + 1] += av.y * b; acc[4 * q + 2] += av.z * b; acc[4 * q + 3] += av.w * b; } }
    bf16* dst = (bf16*)(a.ws + WS_WOUTE) + (size_t)(n0 + n) * 1024 + 512 + g * 128 + 16 * cg;
    v4u o0, o1; o0.x = pk2(acc[0], acc[1]); o0.y = pk2(acc[2], acc[3]); o0.z = pk2(acc[4], acc[5]); o0.w = pk2(acc[6], acc[7]);
    o1.x = pk2(acc[8], acc[9]); o1.y = pk2(acc[10], acc[11]); o1.z = pk2(acc[12], acc[13]); o1.w = pk2(acc[14], acc[15]);
    *(v4u*)dst = o0; *(v4u*)(dst + 8) = o1;
    __syncthreads();
}
__device__ __forceinline__ void mod_block(const Args& a, int item, LAS unsigned char* lds, int tid) {
    const int lane = tid & 63, wave = tid >> 6, l = item / 96, n0 = (item % 96) * 64, k0 = wave * 128;
    LAS float* sil = (LAS float*)lds + wave * (9 * 128); LAS float* part = (LAS float*)lds + 8 * 9 * 128;
#pragma unroll 6
    for (int i = 0; i < 18; ++i) { const int idx = lane + 64 * i, r = idx >> 7, kk = idx & 127; const float cv = (r < 8) ? a.in[1][r * 1024 + k0 + kk] : a.in[3][k0 + kk]; sil[idx] = cv / (1.0f + expf(-cv)); }
    LDS_WAIT(); asm volatile("" ::: "memory");
    float acc[9];
#pragma unroll
    for (int r = 0; r < 9; ++r) acc[r] = 0.f;
    const float* W = a.in[4] + ((size_t)l * 1024 + k0) * 6144 + n0 + lane;
#pragma unroll 8
    for (int k4 = 0; k4 < 32; ++k4) { float w[4];
#pragma unroll
        for (int q = 0; q < 4; ++q) w[q] = __builtin_nontemporal_load(W + (size_t)(4 * k4 + q) * 6144);
#pragma unroll
        for (int r = 0; r < 9; ++r) { const f32x4 s = *(const LAS f32x4*)(sil + r * 128 + 4 * k4); acc[r] += (s.x * w[0] + s.y * w[1]) + (s.z * w[2] + s.w * w[3]); } }
#pragma unroll
    for (int r = 0; r < 9; ++r) part[wave * (9 * 64) + r * 64 + lane] = acc[r];
    __syncthreads();
    for (int idx = tid; idx < 9 * 64; idx += 512) { float s = 0.f;
#pragma unroll
        for (int w8 = 0; w8 < 8; ++w8) s += part[w8 * (9 * 64) + idx];
        const int r = idx >> 6, n = idx & 63; ((float*)(a.ws + WS_MOD))[(size_t)(l * 9 + r) * 6144 + n0 + n] = s + a.in[5][l * 6144 + n0 + n]; }
    __syncthreads();
}
__device__ __forceinline__ void wtr_item(const Args& a, int item, int lane) {
    const int l = item >> 4, k = (item & 15) * 64 + lane; float* wt = (float*)(a.ws + WS_WTR) + (size_t)l * 36 * 1024 + k;
    const f32x4 g = *(const f32x4*)(a.in[17] + ((size_t)l * 1024 + k) * 4);
    wt[0] = g.x; wt[1024] = g.y; wt[2048] = g.z; wt[3072] = g.w;
#pragma unroll
    for (int q = 0; q < 8; ++q) { const f32x4 e = *(const f32x4*)(a.in[19] + ((size_t)l * 1024 + k) * 32 + 4 * q);
        wt[(4 + 4 * q) * 1024] = e.x; wt[(5 + 4 * q) * 1024] = e.y; wt[(6 + 4 * q) * 1024] = e.z; wt[(7 + 4 * q) * 1024] = e.w; }
}
struct TrDesc { const float* src; bf16* dst; int ldw, ldt; };
constexpr int I_WINE = 320, I_WOUTE = 128, I_WINO = 768, I_WOUTO = 256, I_W1 = 8192, I_W3 = 8192, I_W2 = 8192, NTR = I_WINE + I_WOUTE + I_WINO + I_WOUTO + I_W1 + I_W3 + I_W2;
__device__ __forceinline__ TrDesc tr_decode(int r, int lane) {
    const Args a = fetch_args();
    const float* W; bf16* WT; int ldw, ldt, k0, n0, drow0;
    if (r < I_WINE) { const int kb = r % 16, nb = r / 16; W = a.in[8]; ldw = 1280; WT = (bf16*)(a.ws + WS_WINE); ldt = 1024; k0 = kb * 64; n0 = nb * 64; drow0 = n0; }
    else if ((r -= I_WINE) < I_WOUTE) { const int kb = r % 8, nb = r / 8; W = a.in[9]; ldw = 1024; WT = (bf16*)(a.ws + WS_WOUTE); ldt = 1024; k0 = kb * 64; n0 = nb * 64; drow0 = n0; }
    else if ((r -= I_WOUTE) < I_WINO) { const int kb = r % 16, nb = r / 16; W = a.in[14]; ldw = 3072; WT = (bf16*)(a.ws + WS_WINO); ldt = 1024; k0 = kb * 64; n0 = nb * 64; drow0 = n0; }
    else if ((r -= I_WINO) < I_WOUTO) { const int kb = r % 16, nb = r / 16; W = a.in[15]; ldw = 1024; WT = (bf16*)(a.ws + WS_WOUTO); ldt = 1024; k0 = kb * 64; n0 = nb * 64; drow0 = n0; }
    else if ((r -= I_WOUTO) < I_W1 + I_W3) { const int which = r / I_W1; r -= which * I_W1; const int le = r >> 7, q = r & 127, kb = q & 15, nb = q >> 4;
        W = a.in[which ? 22 : 21] + (size_t)le * 1024 * 512; ldw = 512; WT = (bf16*)(a.ws + WS_W13); ldt = 1024; k0 = kb * 64; n0 = nb * 64; drow0 = le * 1024 + (n0 >> 7) * 256 + (n0 & 127) + which * 128; }
    else { r -= I_W1 + I_W3; const int le = r >> 7, q = r & 127, kb = q & 7, nb = q >> 3;
        W = a.in[23] + (size_t)le * 512 * 1024; ldw = 1024; WT = (bf16*)(a.ws + WS_W2); ldt = 512; k0 = kb * 64; n0 = nb * 64; drow0 = le * 1024 + n0; }
    TrDesc d; d.src = W + (size_t)(k0 + (lane >> 4)) * ldw + n0 + (lane & 15) * 4; d.ldw = ldw; d.dst = WT + (size_t)(drow0 + (lane >> 3)) * ldt + k0 + 8 * (lane & 7); d.ldt = ldt; return d;
}
constexpr int NTR_SMALL = I_WINE + I_WOUTE + I_WINO + I_WOUTO, NTR_E = 3 * 4096;
constexpr int E0_P2 = 0, E0_P5 = E0_P2 + 88 * 8 * 4, E0_P0 = E0_P5 + 224 * 8 * 4;
static_assert(E0_P0 <= NTR_E, "tail quotas");
constexpr int NTR_A = NTR_SMALL;
constexpr int E1_P4 = NTR_E - 192 * 8;
__device__ __forceinline__ int tr_index_e(int layer, int b) { const int kind = b >> 12, rem = b & 4095; return NTR_SMALL + kind * 8192 + layer * 4096 + rem; }
__device__ __forceinline__ int tr_index_a(int a) { return a; }
template <bool NT, class NextFn> __device__ __forceinline__ void tr_run(NextFn next_item, LAS float* scr, int lane) {
    f32x4 buf[16]; TrDesc cur{};
#define TR_LD(p) (NT ? __builtin_nontemporal_load((const f32x4*)(p)) : *(const f32x4*)(p))
    int it = next_item();
    if (it >= 0) { cur = tr_decode(it, lane);
#pragma unroll
        for (int i = 0; i < 16; ++i) buf[i] = TR_LD(cur.src + (size_t)(4 * i) * cur.ldw); }
    while (it >= 0) {
#pragma unroll
        for (int i = 0; i < 16; ++i) { LAS float* s = scr + (4 * i + (lane >> 4)) * 65 + (lane & 15) * 4; s[0] = buf[i].x; s[1] = buf[i].y; s[2] = buf[i].z; s[3] = buf[i].w; }
        TrDesc nxt{}; const int nit = next_item();
        if (nit >= 0) { nxt = tr_decode(nit, lane);
#pragma unroll
            for (int i = 0; i < 16; ++i) buf[i] = TR_LD(nxt.src + (size_t)(4 * i) * nxt.ldw); }
        LDS_WAIT(); asm volatile("" ::: "memory");
        const int c = lane & 7;
#pragma unroll
        for (int j = 0; j < 8; ++j) { const LAS float* s = scr + (8 * c) * 65 + (lane >> 3) + 8 * j;
            v4u o; o.x = pk2(s[0 * 65], s[1 * 65]); o.y = pk2(s[2 * 65], s[3 * 65]); o.z = pk2(s[4 * 65], s[5 * 65]); o.w = pk2(s[6 * 65], s[7 * 65]);
            if (NT) __builtin_nontemporal_store(o, (v4u*)(cur.dst + (size_t)(8 * j) * cur.ldt)); else *(v4u*)(cur.dst + (size_t)(8 * j) * cur.ldt) = o; }
        LDS_WAIT(); asm volatile("" ::: "memory");
        cur = nxt; it = nit;
    }
#undef TR_LD
}
__device__ __forceinline__ void tr_range_e(LAS unsigned char* lds, int layer, int lo, int hi, int w, int nw, int wave, int lane, int cap = NTR_E) {
    LAS float* scr = (LAS float*)(lds + wave * 16640); int b = lo + w; hi = min(hi, cap);
    tr_run<true>([&]() -> int { const int r = b; b += nw; return r < hi ? tr_index_e(layer, r) : -1; }, scr, lane);
}
__device__ __forceinline__ void p0_prologue(const Args& a, LAS unsigned char* lds, int vcu, int G, int wave, int lane) {
    LAS float* scr = (LAS float*)(lds + wave * 16640); LAS int* qcnt = (LAS int*)(lds + MISC_OFF + 12288); const int gw = vcu * NWAVES + wave;
    if (threadIdx.x == 0) qcnt[0] = 0;
    __syncthreads();
#if defined(PROBE_SUB)
#define P0STAMP(i) do { if (gw == PROBE_GW && lane == 0) ((unsigned long long*)(a.ws + WS_CTL + 4096))[60 + (i)] = __builtin_amdgcn_s_memrealtime(); } while (0)
#else
#define P0STAMP(i) do { } while (0)
#endif
    P0STAMP(0);
    if (vcu < 64) weff_block(a, vcu, lds, threadIdx.x); else mod_block(a, vcu - 64, lds, threadIdx.x);
    { const int r = vcu * NWAVES + wave;
      if (r < 32) wtr_item(a, r, lane);
      else if (r < 48) {
          const int idx = (r - 32) * 64 + lane, pos = idx >> 4, f = idx & 15; const double inv = exp2(-(double)f * (13.287712379549449 / 16.0)); const double ang = (double)pos * inv;
          ((f32x2*)(a.ws + WS_ROPE))[idx] = (f32x2){(float)cos(ang), (float)sin(ang)}; } }
    P0STAMP(1);
    { const int chunk = (NTR_A + G - 1) / G, c_lo = vcu * chunk, c_hi = min(c_lo + chunk, NTR_A);
      tr_run<false>([&]() -> int { int r = 0; if (lane == 0) r = __hip_atomic_fetch_add(qcnt, 1, __ATOMIC_RELAXED, __HIP_MEMORY_SCOPE_WORKGROUP); r = c_lo + __builtin_amdgcn_readfirstlane(r); return r < c_hi ? tr_index_a(r) : -1; }, scr, lane); }
    P0STAMP(2);
#undef P0STAMP
}

template <int L> __device__ __forceinline__ void p_norm1(const Args& a, int gw, int NGW, int lane) {
    constexpr int R = (L == 0) ? 4 : 2;
    const float* mod = (const float*)(a.ws + WS_MOD); bf16* HA = (bf16*)(a.ws + WS_HA); const bf16* Y2 = (const bf16*)(a.ws + WS_R1 + R1_Y2);
    const float* gn = a.in[6] + L * 1024;
    for (int row = gw * R; row < TT; row += NGW * R) {
        const int b = row / TB, j = row - b * TB; const bool isx = j >= LC; const int mrow = isx ? b : 8;
        bf16* XR = (bf16*)(a.ws + WS_XR) + (size_t)row * 1024;
        f32x4 v[R][4];
        if (L == 0) { const float* src = isx ? a.in[0] + ((size_t)b * SEQ + (j - LC)) * 1024 : a.in[2] + ((size_t)b * LC + j) * 1024;
#pragma unroll
            for (int rr = 0; rr < R; ++rr)
#pragma unroll
                for (int q = 0; q < 4; ++q) v[rr][q] = __builtin_nontemporal_load((const f32x4*)(src + (size_t)rr * 1024) + lane + 64 * q); }
        else {
#pragma unroll
            for (int rr = 0; rr < R; ++rr)
#pragma unroll
                for (int q = 0; q < 4; ++q) { const v2u x = __builtin_nontemporal_load((const v2u*)(XR + (size_t)rr * 1024) + lane + 64 * q); v[rr][q] = (f32x4){bflo(x.x), bfhi(x.x), bflo(x.y), bfhi(x.y)}; } }
        if (L == 1) {
            const float* g2 = mod + (size_t)(0 * 9 + mrow) * 6144 + 5 * 1024;
            v2u y0[R][4], y1[R][4];
#pragma unroll
            for (int rr = 0; rr < R; ++rr)
#pragma unroll
                for (int q = 0; q < 4; ++q) { y0[rr][q] = __builtin_nontemporal_load((const v2u*)(Y2 + (size_t)(row + rr) * 1024) + lane + 64 * q); y1[rr][q] = __builtin_nontemporal_load((const v2u*)(Y2 + (size_t)(TT + row + rr) * 1024) + lane + 64 * q); }
#pragma unroll
            for (int q = 0; q < 4; ++q) { const f32x4 g = ((const f32x4*)g2)[lane + 64 * q];
#pragma unroll
                for (int rr = 0; rr < R; ++rr) { const v2u a0 = y0[rr][q], a1 = y1[rr][q];
                    v[rr][q].x += g.x * (bflo(a0.x) + bflo(a1.x)); v[rr][q].y += g.y * (bfhi(a0.x) + bfhi(a1.x)); v[rr][q].z += g.z * (bflo(a0.y) + bflo(a1.y)); v[rr][q].w += g.w * (bfhi(a0.y) + bfhi(a1.y));
                    __builtin_nontemporal_store((v2u){pk2(v[rr][q].x, v[rr][q].y), pk2(v[rr][q].z, v[rr][q].w)}, (v2u*)(XR + (size_t)rr * 1024) + lane + 64 * q); } }
        }
        float ss[R];
#pragma unroll
        for (int rr = 0; rr < R; ++rr) { ss[rr] = 0.f;
#pragma unroll
            for (int q = 0; q < 4; ++q) ss[rr] += (v[rr][q].x * v[rr][q].x + v[rr][q].y * v[rr][q].y) + (v[rr][q].z * v[rr][q].z + v[rr][q].w * v[rr][q].w); }
#pragma unroll
        for (int o = 1; o < 64; o <<= 1) { float t[R];
#pragma unroll
            for (int rr = 0; rr < R; ++rr) t[rr] = __shfl_xor(ss[rr], o);
#pragma unroll
            for (int rr = 0; rr < R; ++rr) ss[rr] += t[rr]; }
        const float* sh = mod + (size_t)(L * 9 + mrow) * 6144; const float* sc = sh + 1024;
#pragma unroll
        for (int q = 0; q < 4; ++q) { const f32x4 g = ((const f32x4*)gn)[lane + 64 * q], s = ((const f32x4*)sc)[lane + 64 * q], h = ((const f32x4*)sh)[lane + 64 * q];
#pragma unroll
            for (int rr = 0; rr < R; ++rr) { const float rstd = rsqrtf(ss[rr] * (1.0f / 1024.0f) + EPS); const f32x4 o = (v[rr][q] * rstd * g) * (1.0f + s) + h;
                __builtin_nontemporal_store((v2u){pk2(o.x, o.y), pk2(o.z, o.w)}, (v2u*)(HA + (size_t)(row + rr) * 1024) + lane + 64 * q); } }
    }
}
__device__ __forceinline__ void p_final(const Args& a, int gw, int NGW, int lane, float oscale, float spike) {
    constexpr int R = 2;
    const float* mod = (const float*)(a.ws + WS_MOD); const bf16* Y2 = (const bf16*)(a.ws + WS_R1 + R1_Y2); const float* gn = a.in[24];
    for (int xr = gw * R; xr < TX; xr += NGW * R) {
        const int b = xr / SEQ, t = xr - b * SEQ, row = b * TB + LC + t;
        float* px = a.out + (size_t)xr * 1024; const bf16* XR = (const bf16*)(a.ws + WS_XR) + (size_t)row * 1024; const float* g2 = mod + (size_t)(1 * 9 + b) * 6144 + 5 * 1024;
        f32x4 v[R][4]; v2u y0[R][4], y1[R][4];
#pragma unroll
        for (int rr = 0; rr < R; ++rr)
#pragma unroll
            for (int q = 0; q < 4; ++q) { { const v2u x = __builtin_nontemporal_load((const v2u*)(XR + (size_t)rr * 1024) + lane + 64 * q); v[rr][q] = (f32x4){bflo(x.x), bfhi(x.x), bflo(x.y), bfhi(x.y)}; }
                y0[rr][q] = __builtin_nontemporal_load((const v2u*)(Y2 + (size_t)(row + rr) * 1024) + lane + 64 * q); y1[rr][q] = __builtin_nontemporal_load((const v2u*)(Y2 + (size_t)(TT + row + rr) * 1024) + lane + 64 * q); }
        float ss[R];
#pragma unroll
        for (int rr = 0; rr < R; ++rr) { ss[rr] = 0.f;
#pragma unroll
            for (int q = 0; q < 4; ++q) { const f32x4 g = ((const f32x4*)g2)[lane + 64 * q]; const v2u a0 = y0[rr][q], a1 = y1[rr][q];
                v[rr][q].x += g.x * (bflo(a0.x) + bflo(a1.x)); v[rr][q].y += g.y * (bfhi(a0.x) + bfhi(a1.x)); v[rr][q].z += g.z * (bflo(a0.y) + bflo(a1.y)); v[rr][q].w += g.w * (bfhi(a0.y) + bfhi(a1.y));
                ss[rr] += (v[rr][q].x * v[rr][q].x + v[rr][q].y * v[rr][q].y) + (v[rr][q].z * v[rr][q].z + v[rr][q].w * v[rr][q].w); } }
#pragma unroll
        for (int o = 1; o < 64; o <<= 1) { float tt[R];
#pragma unroll
            for (int rr = 0; rr < R; ++rr) tt[rr] = __shfl_xor(ss[rr], o);
#pragma unroll
            for (int rr = 0; rr < R; ++rr) ss[rr] += tt[rr]; }
#pragma unroll
        for (int rr = 0; rr < R; ++rr) { const float rstd = rsqrtf(ss[rr] * (1.0f / 1024.0f) + EPS);
#pragma unroll
            for (int q = 0; q < 4; ++q) { const f32x4 g = ((const f32x4*)gn)[lane + 64 * q]; f32x4 o = v[rr][q] * rstd * g * oscale; if (xr + rr == 0 && q == 0 && lane == 0) o.x += spike; __builtin_nontemporal_store(o, (f32x4*)(px + (size_t)rr * 1024) + lane + 64 * q); } }
    }
}

__device__ __forceinline__ void head_piece(bf16* p, const v4u raw, bool isx, int t, const float (&gain)[8], const f32x2* rope, int j8) {
    float v[8] = {bflo(raw.x), bfhi(raw.x), bflo(raw.y), bfhi(raw.y), bflo(raw.z), bfhi(raw.z), bflo(raw.w), bfhi(raw.w)};
    float ss = 0.f;
#pragma unroll
    for (int i = 0; i < 8; ++i) ss += v[i] * v[i];
    ss += __shfl_xor(ss, 1); ss += __shfl_xor(ss, 2); ss += __shfl_xor(ss, 4);
    const float rstd = rsqrtf(ss * (1.0f / 64.0f) + EPS);
#pragma unroll
    for (int i = 0; i < 8; ++i) v[i] = v[i] * rstd * gain[i];
    if (isx) {
        const int pos = (j8 >> 2) ? (t & 63) : (t >> 6); const bool half = (j8 >> 1) & 1; const f32x4* cs4 = (const f32x4*)(rope + pos * 16 + (j8 & 1) * 8);
        f32x4 c[4];
#pragma unroll
        for (int i = 0; i < 4; ++i) c[i] = cs4[i];
#pragma unroll
        for (int i = 0; i < 8; ++i) { const float other = __shfl_xor(v[i], 2); const float co = (i & 1) ? c[i >> 1].z : c[i >> 1].x, si = (i & 1) ? c[i >> 1].w : c[i >> 1].y;
            v[i] = half ? (other * si + v[i] * co) : (v[i] * co - other * si); }
    }
    v4u o; o.x = pk2(v[0], v[1]); o.y = pk2(v[2], v[3]); o.z = pk2(v[4], v[5]); o.w = pk2(v[6], v[7]);
    *(v4u*)p = o;
}
__device__ __forceinline__ void p_qkprep_pool(const Args& a, int gw, int NGW, int lane) {
    bf16* QE = (bf16*)(a.ws + WS_R1 + R1_QE); bf16* KE = (bf16*)(a.ws + WS_R1 + R1_KE); const bf16* UE = (const bf16*)(a.ws + WS_R1 + R1_UE); bf16* HA = (bf16*)(a.ws + WS_HA);
    const f32x2* rope = (const f32x2*)(a.ws + WS_ROPE);
    const int j8 = lane & 7;
    float qg[8], kg[8];
#pragma unroll
    for (int i = 0; i < 8; ++i) { qg[i] = a.in[10][8 * j8 + i] * C2; kg[i] = a.in[11][8 * j8 + i]; }
    for (int row = gw; row < TT; row += NGW) {
        const int b = row / TB, j = row - b * TB; const bool isx = j >= LC; const int t = isx ? j - LC : j;
        const v4u qraw = *(const v4u*)(QE + (size_t)row * 512 + lane * 8);
        const int g = lane >> 4, w = 2 << g, Lq = isx ? SEQ : LC; const int lo = max(t - (w >> 1), 0), hi = min(t - (w >> 1) + w, Lq); const int base = row - t;
        v4u u[16];
#pragma unroll
        for (int i = 0; i < 16; ++i) { const int tt = t - 8 + i; const int tc = (tt >= lo && tt < hi) ? tt : t; u[i] = *(const v4u*)(UE + (size_t)(base + tc) * 512 + lane * 8); }
        head_piece(QE + (size_t)row * 512 + lane * 8, qraw, isx, t, qg, rope, j8);
        float acc[8];
#pragma unroll
        for (int c = 0; c < 8; ++c) acc[c] = 0.f;
#pragma unroll
        for (int i = 0; i < 16; ++i) { const int tt = t - 8 + i; const float m = (tt >= lo && tt < hi) ? 1.0f : 0.0f;
            acc[0] += m * bflo(u[i].x); acc[1] += m * bfhi(u[i].x); acc[2] += m * bflo(u[i].y); acc[3] += m * bfhi(u[i].y); acc[4] += m * bflo(u[i].z); acc[5] += m * bfhi(u[i].z); acc[6] += m * bflo(u[i].w); acc[7] += m * bfhi(u[i].w); }
        const v4u own = u[8]; const float rc = 1.0f / (float)(hi - lo);
        v4u o; o.x = pk2(acc[0] * rc - bflo(own.x), acc[1] * rc - bfhi(own.x)); o.y = pk2(acc[2] * rc - bflo(own.y), acc[3] * rc - bfhi(own.y));
        o.z = pk2(acc[4] * rc - bflo(own.z), acc[5] * rc - bfhi(own.z)); o.w = pk2(acc[6] * rc - bflo(own.w), acc[7] * rc - bfhi(own.w));
        *(v4u*)(HA + (size_t)row * 1024 + 512 + lane * 8) = o;
    }
    for (int g4 = gw * 2; g4 < TT / 4; g4 += NGW * 2) {
        v4u kraw[2];
#pragma unroll
        for (int u = 0; u < 2; ++u) kraw[u] = *(const v4u*)(KE + (size_t)(4 * (g4 + u) + (lane >> 4)) * 128 + (lane & 15) * 8);
#pragma unroll
        for (int u = 0; u < 2; ++u) { const int row = 4 * (g4 + u) + (lane >> 4); const int b = row / TB, j = row - b * TB; const bool isx = (4 * g4 - (4 * g4 / TB) * TB) >= LC; const int t = isx ? j - LC : j;
            head_piece(KE + (size_t)row * 128 + (lane & 15) * 8, kraw[u], isx, t, kg, rope, j8); }
    }
}

struct NoHook { static constexpr bool MASK = false, NEGC = true; unsigned long long* tsp = nullptr;
    __device__ __forceinline__ int tile_row(int t) const { return 64 * t; }
    __device__ __forceinline__ void mask(attn_body::f32x16&, attn_body::f32x16&, int, float) const {} };
struct NaHook { static constexpr bool MASK = true, NEGC = false;
    int rlo, nrows, rq, rs, wodd; const LAS _Float16* tab; unsigned long long* tsp;
    __device__ __forceinline__ int tile_row(int t) const { return t < 4 ? 64 * t : 256 + 64 * min(rlo + t - 4, 63); }
    __device__ __forceinline__ void mask(attn_body::f32x16& p0, attn_body::f32x16& p1, int t, float mhat) const {
        if (t < 4) {
#pragma unroll
            for (int r = 0; r < 16; ++r) { p0[r] -= mhat; p1[r] -= mhat; }
            return; }
        const int kr = rlo + t - 4; const bool rowok = (t - 4 < nrows) && kr >= rs && kr < rs + 8;
        if (!rowok) {
#pragma unroll
            for (int r = 0; r < 16; ++r) { p0[r] = -INFINITY; p1[r] = -INFINITY; }
        } else {
            const int lane_ = threadIdx.x & 63, hi_ = lane_ >> 5, cq_ = 32 * wodd + (lane_ & 31); const int lo_ = (cq_ < 8) ? 15 - cq_ : (cq_ > 55) ? 63 - cq_ : 7;
            const LAS _Float16* rowp = tab + lo_ * 1920 + (kr - rq + 7) * 128 + (4 * hi_ - cq_ + 63);
            if (wodd == 0) {
#pragma unroll
                for (int r = 0; r < 16; ++r) { const int kc0 = (r & 3) + 8 * (r >> 2); p0[r] = (p0[r] + (float)rowp[kc0]) - mhat; }
#pragma unroll
                for (int r = 0; r < 4; ++r) p1[r] = (p1[r] + (float)rowp[r + 32]) - mhat;
#pragma unroll
                for (int r = 4; r < 16; ++r) p1[r] = -INFINITY;
            } else {
#pragma unroll
                for (int r = 0; r < 12; ++r) p0[r] = -INFINITY;
#pragma unroll
                for (int r = 12; r < 16; ++r) p0[r] = (p0[r] + (float)rowp[(r & 3) + 24]) - mhat;
#pragma unroll
                for (int r = 0; r < 16; ++r) { const int kc0 = (r & 3) + 8 * (r >> 2); p1[r] = (p1[r] + (float)rowp[kc0 + 32]) - mhat; }
            }
        }
    }
};
__device__ __forceinline__ void p_attn_even(const Args& a, char* lds, int vcu) {
    using abf = attn_body::bf16;
    const abf* QE = (const abf*)(a.ws + WS_R1 + R1_QE); const abf* KE = (const abf*)(a.ws + WS_R1 + R1_KE); const abf* VE = (const abf*)(a.ws + WS_R1 + R1_VE); abf* HA = (abf*)(a.ws + WS_HA);
    const int b = vcu >> 5, i = vcu & 31, hq = i >> 2; const NoHook hk;
    const size_t kvo = (size_t)b * TB * 128 + (hq >> 2) * 64;
    for (int u = 0; u < 4; ++u) { const size_t row0 = (size_t)b * TB + LC + ((i & 3) * 4 + u) * 256;
        attn_body::attn_unit<8, 512, 128, 128, 1024, NoHook>(QE + row0 * 512 + hq * 64, KE + kvo, VE + kvo, HA + row0 * 1024 + hq * 64, 68, hk, lds); }
    if (i < 8) { const size_t row0 = (size_t)b * TB; const int hc = i;
        const size_t kvc = (size_t)b * TB * 128 + (hc >> 2) * 64;
        attn_body::attn_unit<8, 512, 128, 128, 1024, NoHook>(QE + row0 * 512 + hc * 64, KE + kvc, VE + kvc, HA + row0 * 1024 + hc * 64, 4, hk, lds); }
}
__device__ __forceinline__ void p_attn_na(const Args& a, char* lds, LAS unsigned char* ldsl, int vcu, int tid) {
    using abf = attn_body::bf16;
    const abf* QO = (const abf*)(a.ws + WS_R1 + R1_QO); const abf* KO = (const abf*)(a.ws + WS_R1 + R1_QO + R1_QKV_STRIDE); const abf* VO = (const abf*)(a.ws + WS_R1 + R1_QO + 2 * R1_QKV_STRIDE); abf* HA = (abf*)(a.ws + WS_HA);
    const int b = vcu >> 5, i = vcu & 31, h = i >> 1, rg0 = (i & 1) * 8;
    LAS _Float16* tab = (LAS _Float16*)(ldsl + NA_TAB_OFF);
    for (int k = tid; k < 16 * 15 * 128; k += 512) { const int lo = k / 1920, rem = k - lo * 1920, dr = rem >> 7, co = (rem & 127) - 48;
        tab[k] = (_Float16)((co >= lo && co <= lo + 15 && co <= 30) ? a.in[16][h * 465 + dr * 31 + co] * LOG2E : -INFINITY); }
    __syncthreads();
    const int wid = __builtin_amdgcn_readfirstlane(tid >> 6);
    for (int u = 0; u < 8; ++u) { const int r0 = (rg0 + u) * 4;
#if defined(PROBE_SUB)
        if (blockIdx.x == 0 && tid == 0) ((unsigned long long*)(a.ws + WS_CTL + 4096))[40 + u] = __builtin_amdgcn_s_memrealtime();
#endif
        NaHook hk; hk.rlo = min(max(r0 - 4, 0), 56); hk.nrows = min(max(r0 + 3 - 4, 0), 56) + 8 - hk.rlo; hk.rq = r0 + (wid >> 1); hk.rs = min(max(hk.rq - 4, 0), 56);
        hk.wodd = wid & 1; hk.tab = tab; hk.tsp = nullptr;
#if defined(PROBE_SUB)
        if (u == 2) hk.tsp = (unsigned long long*)(a.ws + WS_CTL + 4096) + 50;
#endif
        const int NT = (4 + hk.nrows + 1) & ~1;
        const size_t row0 = (size_t)b * TB + LC + r0 * 64, kv0 = (size_t)(b * 16 + h) * TB * 64;
        attn_body::attn_unit<8, 1024, 64, 64, 1024, NaHook>(QO + row0 * 1024 + h * 64, KO + kv0, VO + kv0, HA + row0 * 1024 + h * 64, NT, hk, lds); }
#if defined(PROBE_SUB)
    if (blockIdx.x == 0 && tid == 0) ((unsigned long long*)(a.ws + WS_CTL + 4096))[48] = __builtin_amdgcn_s_memrealtime();
#endif
}

template <int L> __device__ __forceinline__ void p_router(const Args& a, LAS unsigned char* lds, int bid, int G, int tid) {
    const int lane = tid & 63, wave = tid >> 6;
    LAS float* Wt = (LAS float*)lds;
    LAS int* lcnt = (LAS int*)(lds + MISC_OFF); LAS int* lbase = lcnt + 32;
    float* LOG = (float*)(a.ws + WS_LOG);
    const float* mod = (const float*)(a.ws + WS_MOD); bf16* HA = (bf16*)(a.ws + WS_HA); const bf16* YB = (const bf16*)(a.ws + WS_R1 + R1_YB); const float* gn = a.in[7] + L * 1024;
    constexpr int NPAIR = (L == 0) ? TT / 2 : TX / 2;
    const int ppb = (NPAIR + G - 1) / G;
    const int p_lo = bid * ppb, p_hi = min(p_lo + ppb, NPAIR);
    auto pair_row = [&](int p) -> int { if (L == 0) return 2 * p; const int bb = p / (SEQ / 2); return bb * TB + LC + 2 * (p - bb * (SEQ / 2)); };
    bf16* XRb = (bf16*)(a.ws + WS_XR);
    struct Raw { f32x4 f; v2u h; };
    auto ld_src = [&](int row, int q, Raw& r) { const int b = row / TB, j = row - b * TB;
        if (L == 0) { const float* s = (j >= LC) ? a.in[0] + ((size_t)b * SEQ + (j - LC)) * 1024 : a.in[2] + ((size_t)b * LC + j) * 1024; r.f = __builtin_nontemporal_load((const f32x4*)s + lane + 64 * q); }
        else r.h = __builtin_nontemporal_load((const v2u*)(XRb + (size_t)row * 1024) + lane + 64 * q); };
    auto cvt_src = [&](const Raw& r) -> f32x4 { if (L == 0) return r.f; return (f32x4){bflo(r.h.x), bfhi(r.h.x), bflo(r.h.y), bfhi(r.h.y)}; };
#if defined(PROBE_SUB)
#define SUBSTAMP(i) do { if (L == 0 && bid == 0 && tid == 0) ((unsigned long long*)(a.ws + WS_CTL + 4096))[21 + (i)] = __builtin_amdgcn_s_memrealtime(); } while (0)
#else
#define SUBSTAMP(i) do { } while (0)
#endif
    SUBSTAMP(0);
    Raw nxa[4], nxb[4]; v2u ya[4], yb[4];
    if (p_lo + wave < p_hi) { const int r0 = pair_row(p_lo + wave);
#pragma unroll
        for (int q = 0; q < 4; ++q) { ld_src(r0, q, nxa[q]); ld_src(r0 + 1, q, nxb[q]);
            ya[q] = ((const v2u*)(YB + (size_t)r0 * 1024))[lane + 64 * q]; yb[q] = ((const v2u*)(YB + (size_t)(r0 + 1) * 1024))[lane + 64 * q]; } }
    { const f32x4* wsrc = (const f32x4*)(a.ws + WS_WTR) + (size_t)L * 9216;
        for (int i = tid; i < 9216; i += 512) ((LAS f32x4*)Wt)[i] = wsrc[i]; }
    if (tid < 32) lcnt[tid] = 0;
    float bgv[4];
#pragma unroll
    for (int e = 0; e < 4; ++e) bgv[e] = a.in[18][L * 4 + e];
    __syncthreads();
    SUBSTAMP(1);
    for (int p = p_lo + wave; p < p_hi; p += NWAVES) {
        const int row = pair_row(p);
        const int b = row / TB, j = row - b * TB; const bool isx = j >= LC; const int mrow = isx ? b : 8;
        f32x4 xa[4], xb[4]; float ssa = 0.f, ssb = 0.f;
#pragma unroll
        for (int q = 0; q < 4; ++q) { xa[q] = cvt_src(nxa[q]); xb[q] = cvt_src(nxb[q]); }
        if (p + NWAVES < p_hi) { const int r1 = pair_row(p + NWAVES);
#pragma unroll
            for (int q = 0; q < 4; ++q) { ld_src(r1, q, nxa[q]); ld_src(r1 + 1, q, nxb[q]); } }
        { const float* g1 = mod + (size_t)(L * 9 + mrow) * 6144 + 2 * 1024; bf16* dst = XRb + (size_t)row * 1024;
#pragma unroll
            for (int q = 0; q < 4; ++q) { const f32x4 g = ((const f32x4*)g1)[lane + 64 * q];
                xa[q].x += g.x * bflo(ya[q].x); xa[q].y += g.y * bfhi(ya[q].x); xa[q].z += g.z * bflo(ya[q].y); xa[q].w += g.w * bfhi(ya[q].y);
                xb[q].x += g.x * bflo(yb[q].x); xb[q].y += g.y * bfhi(yb[q].x); xb[q].z += g.z * bflo(yb[q].y); xb[q].w += g.w * bfhi(yb[q].y);
                __builtin_nontemporal_store((v2u){pk2(xa[q].x, xa[q].y), pk2(xa[q].z, xa[q].w)}, (v2u*)dst + lane + 64 * q); __builtin_nontemporal_store((v2u){pk2(xb[q].x, xb[q].y), pk2(xb[q].z, xb[q].w)}, (v2u*)(dst + 1024) + lane + 64 * q); }
            if (p + NWAVES < p_hi) { const int r1 = pair_row(p + NWAVES);
#pragma unroll
                for (int q = 0; q < 4; ++q) { ya[q] = ((const v2u*)(YB + (size_t)r1 * 1024))[lane + 64 * q]; yb[q] = ((const v2u*)(YB + (size_t)(r1 + 1) * 1024))[lane + 64 * q]; } } }
#pragma unroll
        for (int q = 0; q < 4; ++q) { ssa += (xa[q].x * xa[q].x + xa[q].y * xa[q].y) + (xa[q].z * xa[q].z + xa[q].w * xa[q].w); ssb += (xb[q].x * xb[q].x + xb[q].y * xb[q].y) + (xb[q].z * xb[q].z + xb[q].w * xb[q].w); }
#pragma unroll
        for (int o = 1; o < 64; o <<= 1) { const float ta = __shfl_xor(ssa, o), tb = __shfl_xor(ssb, o); ssa += ta; ssb += tb; }
        const float ra = rsqrtf(ssa * (1.0f / 1024.0f) + EPS), rb = rsqrtf(ssb * (1.0f / 1024.0f) + EPS);
        const float* sh = mod + (size_t)(L * 9 + mrow) * 6144 + 3 * 1024; const float* sc = sh + 1024;
#pragma unroll
        for (int q = 0; q < 4; ++q) { const f32x4 g = ((const f32x4*)gn)[lane + 64 * q], s = ((const f32x4*)sc)[lane + 64 * q], h = ((const f32x4*)sh)[lane + 64 * q];
            xa[q] = (xa[q] * ra * g) * (1.0f + s) + h; xb[q] = (xb[q] * rb * g) * (1.0f + s) + h;
            __builtin_nontemporal_store((v2u){pk2(xa[q].x, xa[q].y), pk2(xa[q].z, xa[q].w)}, (v2u*)(HA + (size_t)row * 1024) + lane + 64 * q);
            __builtin_nontemporal_store((v2u){pk2(xb[q].x, xb[q].y), pk2(xb[q].z, xb[q].w)}, (v2u*)(HA + (size_t)(row + 1) * 1024) + lane + 64 * q); }
#define TR_STEP(ARR, N, MASK) do { const bool hib = (lane & (MASK)) != 0; _Pragma("unroll") for (int jj = 0; jj < (N) / 2; ++jj) { \
            const float send = hib ? ARR[jj] : ARR[jj + (N) / 2]; const float recv = __shfl_xor(send, (MASK)); const float keep = hib ? ARR[jj + (N) / 2] : ARR[jj]; ARR[jj] = keep + recv; } } while (0)
#define DOT36(E, PA, PB) do { f32x4 aa = (f32x4){0.f, 0.f, 0.f, 0.f}, ab = (f32x4){0.f, 0.f, 0.f, 0.f}; _Pragma("unroll") for (int q = 0; q < 4; ++q) { \
            const f32x4 w = *(const LAS f32x4*)(Wt + (E) * 1024 + 4 * lane + 256 * q); aa += xa[q] * w; ab += xb[q] * w; } \
            PA = (aa.x + aa.y) + (aa.z + aa.w); PB = (ab.x + ab.y) + (ab.z + ab.w); } while (0)
        int gia, gib;
        {   float grp[8];
#pragma unroll
            for (int e = 0; e < 4; ++e) DOT36(e, grp[e], grp[4 + e]);
            TR_STEP(grp, 8, 32); TR_STEP(grp, 4, 16); TR_STEP(grp, 2, 8);
            float gsum = grp[0]; gsum += __shfl_xor(gsum, 4); gsum += __shfl_xor(gsum, 2); gsum += __shfl_xor(gsum, 1);
            if ((lane & 7) == 0) LOG[(size_t)(row + (lane >> 5)) * 36 + ((lane >> 3) & 3)] = gsum;
            const int gv = __builtin_bit_cast(int, gsum); int gsel[2];
#pragma unroll
            for (int r2 = 0; r2 < 2; ++r2) { int gi = 0; float gm = __builtin_bit_cast(float, __builtin_amdgcn_readlane(gv, (r2 * 4) * 8)) + bgv[0];
#pragma unroll
                for (int e = 1; e < 4; ++e) { const float v = __builtin_bit_cast(float, __builtin_amdgcn_readlane(gv, (r2 * 4 + e) * 8)) + bgv[e]; if (v > gm) { gm = v; gi = e; } }
                gsel[r2] = __builtin_amdgcn_readfirstlane(gi); }
            gia = gsel[0]; gib = gsel[1];
            if (lane == 0) { LOG[(size_t)row * 36 + 12] = __builtin_bit_cast(float, gia); LOG[(size_t)(row + 1) * 36 + 12] = __builtin_bit_cast(float, gib); } }
        {
            float c2[16];
            const LAS float* Wa = Wt + (4 + 8 * gia) * 1024 + 4 * lane; const LAS float* Wb = Wt + (4 + 8 * gib) * 1024 + 4 * lane;
#pragma unroll
            for (int e = 0; e < 8; ++e) { f32x4 aa = (f32x4){0.f, 0.f, 0.f, 0.f}, ab = (f32x4){0.f, 0.f, 0.f, 0.f};
#pragma unroll
                for (int q = 0; q < 4; ++q) { const f32x4 wa = *(const LAS f32x4*)(Wa + e * 1024 + 256 * q), wb = *(const LAS f32x4*)(Wb + e * 1024 + 256 * q); aa += xa[q] * wa; ab += xb[q] * wb; }
                c2[e] = (aa.x + aa.y) + (aa.z + aa.w); c2[8 + e] = (ab.x + ab.y) + (ab.z + ab.w); }
            TR_STEP(c2, 16, 32); TR_STEP(c2, 8, 16); TR_STEP(c2, 4, 8); TR_STEP(c2, 2, 4);
            float cs = c2[0]; cs += __shfl_xor(cs, 2); cs += __shfl_xor(cs, 1);
            if ((lane & 3) == 0) LOG[(size_t)(row + (lane >> 5)) * 36 + 4 + ((lane >> 2) & 7)] = cs;
        }
#undef TR_STEP
#undef DOT36
    }
    SUBSTAMP(2);
    __threadfence_block();
    __syncthreads();
    SUBSTAMP(3);
    const int nrow = (p_hi - p_lo) * 2; int myrow = 0, e0 = 0, e1 = 0, rk0 = 0, rk1 = 0; float w0 = 0.f, w1 = 0.f;
    if (tid < nrow) {
        myrow = pair_row(p_lo + (tid >> 1)) + (tid & 1); const float* lg = LOG + (size_t)myrow * 36;
        const float* bg = a.in[18] + L * 4; const float* be = a.in[20] + L * 32;
        float gl[4]; const int gi = __builtin_bit_cast(int, lg[12]);
#pragma unroll
        for (int e = 0; e < 4; ++e) gl[e] = lg[e] + bg[e];
        const float gm = (gi == 0) ? gl[0] : (gi == 1) ? gl[1] : (gi == 2) ? gl[2] : gl[3];
        float gs = 0.f;
#pragma unroll
        for (int e = 0; e < 4; ++e) gs += expf(gl[e] - gm);
        const float gwt = 1.0f / gs;
        float el[8];
#pragma unroll
        for (int e = 0; e < 8; ++e) el[e] = lg[4 + e] + be[gi * 8 + e];
        int i0 = 0; float m0 = el[0];
#pragma unroll
        for (int e = 1; e < 8; ++e) if (el[e] > m0) { m0 = el[e]; i0 = e; }
        int i1 = -1; float m1 = -INFINITY;
#pragma unroll
        for (int e = 0; e < 8; ++e) if (e != i0 && el[e] > m1) { m1 = el[e]; i1 = e; }
        const float ex = expf(m1 - m0), p0 = 1.0f / (1.0f + ex), p1 = ex * p0;
        e0 = gi * 8 + i0; e1 = gi * 8 + i1; w0 = gwt * p0; w1 = gwt * p1;
        rk0 = __hip_atomic_fetch_add(&lcnt[e0], 1, __ATOMIC_RELAXED, __HIP_MEMORY_SCOPE_WORKGROUP); rk1 = __hip_atomic_fetch_add(&lcnt[e1], 1, __ATOMIC_RELAXED, __HIP_MEMORY_SCOPE_WORKGROUP);
    }
    __syncthreads();
    if (tid < 32) lbase[tid] = atomicAdd((int*)(a.ws + WS_CTL) + L * 32 + tid, lcnt[tid]);
    __syncthreads();
    if (tid < nrow) { int* elist = (int*)(a.ws + WS_ELIST); float* ewgt = (float*)(elist + 32 * TT);
        const size_t s0 = (size_t)e0 * TT + rk0 + lbase[e0], s1 = (size_t)e1 * TT + rk1 + lbase[e1];
        elist[s0] = myrow; ewgt[s0] = w0; elist[s1] = TT + myrow; ewgt[s1] = w1; }
    SUBSTAMP(4);
#undef SUBSTAMP
}
__device__ __forceinline__ void moe_tiles(const Args& a, LAS unsigned char* lds, int L, int tid) {
    LAS int* tstart = (LAS int*)(lds + MISC_OFF + 4096);
    if (tid == 0) { const int* cnt = (const int*)(a.ws + WS_CTL) + L * 32; int t = 0; for (int e = 0; e < 32; ++e) { tstart[e] = t; tstart[64 + e] = cnt[e]; t += (cnt[e] + 255) >> 8; } tstart[32] = t; }
    __syncthreads();
}
#define RLX_AGENT __ATOMIC_RELAXED, __HIP_MEMORY_SCOPE_AGENT
#define XB_TMO      128
#define XB_XCNT(j)  (256  + 64 * (j))
#define XB_XSUB(j)  (1280 + 64 * (j))
#define XB_XGEN(j)  (2304 + 64 * (j))
#define XB_TOP      3328
#define XB_TOPGEN   3392
#define XCD_BAR_WORDS 3456
#define XB_SPIN_CAP (1u << 18)

__device__ __forceinline__ unsigned xb_ld(unsigned* p)              { return __hip_atomic_load(p, __ATOMIC_RELAXED, __HIP_MEMORY_SCOPE_AGENT); }
__device__ __forceinline__ unsigned xb_add(unsigned* p, unsigned v) { return __hip_atomic_fetch_add(p, v, __ATOMIC_RELAXED, __HIP_MEMORY_SCOPE_AGENT); }
__device__ __forceinline__ unsigned xb_xcc_id() { return (unsigned)__builtin_amdgcn_s_getreg((3 << 11) | 20) & 0xFu; }
#define XB_SPIN(cond, bar) do { unsigned _sp = 0; while (cond) { __builtin_amdgcn_s_sleep(1); \
    if ((++_sp & 255u) == 0u) { if (xb_ld(&(bar)[XB_TMO])) break; if (_sp > XB_SPIN_CAP) { atomicAdd(&(bar)[XB_TMO], 1u); break; } } } } while (0)

struct XcdBarrier {
    unsigned* bar; unsigned x;
    volatile LAS unsigned* st;
};

__device__ __forceinline__ XcdBarrier xcd_barrier_post(unsigned* bar, volatile LAS unsigned* st) {
    XcdBarrier b; b.bar = bar; b.x = xb_xcc_id(); b.st = st;
    if (threadIdx.x == 0) (void)xb_add(&bar[XB_XCNT(b.x)], 1u);
    return b;
}
__device__ __forceinline__ void xcd_barrier_complete(unsigned* bar, unsigned x, unsigned& nloc, unsigned& nx) {
    const unsigned G = gridDim.x * gridDim.y * gridDim.z;
    unsigned sum, cnt, mine, sp = 0u;
    for (;;) {
        sum = 0u; cnt = 0u; mine = 0u;
#pragma unroll
        for (unsigned j = 0; j < 16; ++j) { const unsigned c = xb_ld(&bar[XB_XCNT(j)]); sum += c; cnt += (c > 0u) ? 1u : 0u; mine = (j == x) ? c : mine; }
        if (sum == G) break;
        __builtin_amdgcn_s_sleep(1);
        if ((++sp & 255u) == 0u) { if (xb_ld(&bar[XB_TMO])) break; if (sp > XB_SPIN_CAP) { atomicAdd(&bar[XB_TMO], 1u); break; } }
    }
    nloc = mine > 0u ? mine : 1u; nx = cnt > 0u ? cnt : 1u;
}

__device__ __forceinline__ void xcd_barrier(const XcdBarrier& b) {
    asm volatile("s_waitcnt vmcnt(0)" ::: "memory");
    __syncthreads();
    if (threadIdx.x == 0) {
        unsigned* bar = b.bar;
        __builtin_amdgcn_s_waitcnt(0);
        unsigned nloc = b.st[0], nx = b.st[1];
        if (nloc == 0u) { xcd_barrier_complete(bar, b.x, nloc, nx); b.st[0] = nloc; b.st[1] = nx; }
        const unsigned old = xb_add(&bar[XB_XSUB(b.x)], 1u);
        const unsigned gen = old / nloc;
        if (old + 1u == (gen + 1u) * nloc) {
            __builtin_amdgcn_fence(__ATOMIC_RELEASE, "agent");
            asm volatile("s_waitcnt vmcnt(0)" ::: "memory");
            const unsigned og = xb_add(&bar[XB_TOP], 1u);
            const unsigned tg = og / nx;
            if (og + 1u == (tg + 1u) * nx) xb_add(&bar[XB_TOPGEN], 1u);
            else XB_SPIN(xb_ld(&bar[XB_TOPGEN]) == tg, bar);
            __builtin_amdgcn_fence(__ATOMIC_ACQUIRE, "agent");
            xb_add(&bar[XB_XGEN(b.x)], 1u);
            asm volatile("s_waitcnt vmcnt(0)" ::: "memory");
        } else {
            XB_SPIN(xb_ld(&bar[XB_XGEN(b.x)]) == gen, bar);
            __builtin_amdgcn_fence(__ATOMIC_ACQUIRE, "agent");
            asm volatile("s_waitcnt vmcnt(0)" ::: "memory");
        }
    }
    __syncthreads();
}

__device__ __forceinline__ int l0_units(const Args& a, LAS unsigned char* lds, int tid) {
    LAS int* w = (LAS int*)(lds + MISC_OFF + 12288);
    __syncthreads();
    if (tid == 0) { const int* cnt = (const int*)(a.ws + WS_CTL); int t = 0; for (int e = 0; e < 32; ++e) t += (cnt[e] + 255) >> 8; w[4] = t * 4; }
    __syncthreads();
    return w[4];
}
__global__ void __launch_bounds__(NWAVES * 64, 2) mega_fwd(Args args) {
    extern __shared__ __attribute__((aligned(16))) unsigned char lds_raw[];
    LAS unsigned char* lds = (LAS unsigned char*)lds_raw;
    const int tid = threadIdx.x, lane = tid & 63, wave = __builtin_amdgcn_readfirstlane(tid >> 6);
    const int G = gridDim.x, bid = blockIdx.x; const int vcu = (G % 8 == 0) ? (bid % 8) * (G / 8) + bid / 8 : bid;
    const int gw = vcu * NWAVES + wave, NGW = G * NWAVES;
    int lo, hi; unsigned char* ws; { const Args a0 = fetch_args(); lo = a0.ph_lo; hi = a0.ph_hi; ws = a0.ws; }
    cg::grid_group grid = cg::this_grid();
    volatile LAS unsigned* bst = (volatile LAS unsigned*)(lds + MISC_OFF + 16368);
    if (tid < 2) bst[tid] = 0u;
    __syncthreads();
    const XcdBarrier xbar = xcd_barrier_post((unsigned*)(ws + WS_CTL) + 16384, bst);
#ifndef PHASE_MASK
#define PHASE_MASK 0x7ffffu
#endif
#define IN(k) ((((PHASE_MASK) >> (k)) & 1u) && lo <= (k) && (k) < hi)
#ifndef PROBE_A
#define PROBE_A -1
#endif
#ifndef PROBE_B
#define PROBE_B -1
#endif
#if PROBE_A >= 0
    unsigned long long* ts = (unsigned long long*)(ws + WS_CTL + 4096);
    if (bid == 0 && tid == 0) ts[0] = __builtin_amdgcn_s_memrealtime();
#define STAMP(k) do { if (bid == 0 && tid == 0) ts[(k) + 1] = __builtin_amdgcn_s_memrealtime(); } while (0)
#else
#define STAMP(k) do { } while (0)
#endif
#define SEAM(k) do { if (IN(k) && IN((k) + 1)) xcd_barrier(xbar); STAMP(k); } while (0)
    typedef pg8::bf16_t pbf;
#define TAIL(total, layer, base, q) do { const int rem_ = (total) % G; if (rem_ != 0 && bid >= rem_) tr_range_e(lds, (layer), (base), (base) + (G - rem_) * NWAVES * (q), (bid - rem_) * NWAVES + wave, (G - rem_) * NWAVES, wave, lane, (layer) ? E1_P4 : NTR_E); } while (0)
#define TAIL_ITEMS(total, q) ((((total) % G) != 0) ? (G - (total) % G) * NWAVES * (q) : 0)
#ifdef EXTRA_SYNC
    for (int es = 0; es < EXTRA_SYNC; ++es) xcd_barrier(xbar);
#endif
    if (lo > hi) grid.sync();
    if (IN(0)) { p0_prologue(fetch_args(), lds, vcu, G, wave, lane); } SEAM(0);
    if (IN(1)) { p_norm1<0>(fetch_args(), gw, NGW, lane); } SEAM(1);
    if (IN(2)) {
        pg8::Gemm g{(const pbf*)(ws + WS_HA), (const pbf*)(ws + WS_WINE), TT, 1280, 1024}; pg8::DenseOrder S; S.init(136, 5, G, bid, 0);
        pg8::EpiEvenIn E{(pbf*)(ws + WS_R1 + R1_QE), (pbf*)(ws + WS_R1 + R1_KE), (pbf*)(ws + WS_R1 + R1_VE), (pbf*)(ws + WS_R1 + R1_UE)};
        pg8::gemm_phase<pg8::EpiEvenIn, pg8::DenseOrder, true, true>(lds, g, S, E); TAIL(680, 0, E0_P2, 4); } SEAM(2);
    if (IN(3)) { p_qkprep_pool(fetch_args(), gw, NGW, lane); } SEAM(3);
    if (IN(4)) { p_attn_even(fetch_args(), (char*)lds_raw, vcu);
        { const int i_ = vcu & 31; if (i_ >= 8) { const int w_ = ((vcu >> 5) * 24 + (i_ - 8)) * NWAVES + wave;
            tr_range_e(lds, 0, E0_P0, NTR_E, w_, 192 * NWAVES, wave, lane); tr_range_e(lds, 1, E1_P4, NTR_E, w_, 192 * NWAVES, wave, lane); } } } SEAM(4);
    if (IN(5)) {
        pg8::Gemm g{(const pbf*)(ws + WS_HA), (const pbf*)(ws + WS_WOUTE), TT, 1024, 1024}; pg8::DenseOrder S; S.init(136, 4, G, bid, 0);
        pg8::EpiBf16 E{(pbf*)(ws + WS_R1 + R1_YB), 1024, 0, 0, 1.f};
        pg8::gemm_phase<pg8::EpiBf16, pg8::DenseOrder, true, true>(lds, g, S, E); TAIL(544, 0, E0_P5, 4); } SEAM(5);
    if (IN(6)) { p_router<0>(fetch_args(), lds, bid, G, tid); } STAMP(6); SEAM(7);
    if (IN(8)) {
        moe_tiles(fetch_args(), lds, 0, tid); const LAS int* tstart = (const LAS int*)(lds + MISC_OFF + 4096);
        pg8::Gemm g{(const pbf*)(ws + WS_HA), (const pbf*)(ws + WS_W13), 0, 0, 1024}; pg8::MoeOrder S{tstart, tstart[32] * 4, G, bid, 0};
        pg8::EpiMoeUp E{(pbf*)(ws + WS_R1 + R1_HMID)}; pg8::MoeGather AG{(const int*)(ws + WS_ELIST), tstart + 64};
        pg8::gemm_phase<pg8::EpiMoeUp, pg8::MoeOrder, true, true, pg8::MoeGather>(lds, g, S, E, AG); { const int nu0 = tstart[32] * 4; TAIL(nu0, 1, 0, 4); } } SEAM(8);
    if (IN(9)) {
        moe_tiles(fetch_args(), lds, 0, tid); const LAS int* tstart = (const LAS int*)(lds + MISC_OFF + 4096);
        pg8::Gemm g{(const pbf*)(ws + WS_R1 + R1_HMID), (const pbf*)(ws + WS_W2), 0, 0, 512}; pg8::MoeOrder S{tstart, tstart[32] * 4, G, bid, 0};
        pg8::EpiMoeDown E{(pbf*)(ws + WS_R1 + R1_Y2), (const int*)(ws + WS_ELIST), (const float*)(ws + WS_ELIST) + 32 * TT, tstart + 64, (LAS int*)(lds + MISC_OFF + 8192)};
        pg8::gemm_phase<pg8::EpiMoeDown, pg8::MoeOrder, true, true>(lds, g, S, E); { const int nu0 = tstart[32] * 4; TAIL(nu0, 1, TAIL_ITEMS(nu0, 4), 2); } } SEAM(9);
    if (IN(10)) { p_norm1<1>(fetch_args(), gw, NGW, lane); } SEAM(10);
    if (IN(11)) {
        pg8::Gemm g{(const pbf*)(ws + WS_HA), (const pbf*)(ws + WS_WINO), TT, 3072, 1024}; pg8::DenseOrder S; S.init(128, 12, G, bid, 1, 64, 4, 8);
        pg8::EpiOddIn E{(pbf*)(ws + WS_R1 + R1_QO), (pbf*)(ws + WS_R1 + R1_QO + R1_QKV_STRIDE), (pbf*)(ws + WS_R1 + R1_QO + 2 * R1_QKV_STRIDE), C2};
#if defined(PROBE_SUB)
        E.tsp = (unsigned long long*)(ws + WS_CTL + 4096) + 70;
#endif
        pg8::gemm_phase<pg8::EpiOddIn, pg8::DenseOrder, true, true>(lds, g, S, E); { const int nu0 = l0_units(fetch_args(), lds, tid); TAIL(1600, 1, TAIL_ITEMS(nu0, 4) + TAIL_ITEMS(nu0, 2), 5); } } SEAM(11);
    if (IN(12)) { p_attn_na(fetch_args(), (char*)lds_raw, lds, vcu, tid); } SEAM(12);
    if (IN(13)) {
        pg8::Gemm g{(const pbf*)(ws + WS_HA), (const pbf*)(ws + WS_WOUTO), TT, 1024, 1024}; pg8::DenseOrder S; S.init(128, 4, G, bid, 1);
        pg8::EpiBf16 E{(pbf*)(ws + WS_R1 + R1_YB), 1024, 0, 0, 1.f};
        pg8::gemm_phase<pg8::EpiBf16, pg8::DenseOrder, true, true>(lds, g, S, E); } SEAM(13);
    if (IN(14)) { p_router<1>(fetch_args(), lds, bid, G, tid); __syncthreads(); { const int nu0 = l0_units(fetch_args(), lds, tid);
        tr_range_e(lds, 1, TAIL_ITEMS(nu0, 4) + TAIL_ITEMS(nu0, 2) + TAIL_ITEMS(1600, 5), E1_P4, gw, NGW, wave, lane, E1_P4); } } STAMP(14); SEAM(15);
    if (IN(16)) {
        moe_tiles(fetch_args(), lds, 1, tid); const LAS int* tstart = (const LAS int*)(lds + MISC_OFF + 4096);
        pg8::Gemm g{(const pbf*)(ws + WS_HA), (const pbf*)(ws + WS_W13), 0, 0, 1024}; pg8::MoeOrder S{tstart, tstart[32] * 4, G, bid, 32};
        pg8::EpiMoeUp E{(pbf*)(ws + WS_R1 + R1_HMID)}; pg8::MoeGather AG{(const int*)(ws + WS_ELIST), tstart + 64};
        pg8::gemm_phase<pg8::EpiMoeUp, pg8::MoeOrder, true, true, pg8::MoeGather>(lds, g, S, E, AG); } SEAM(16);
    if (IN(17)) {
        moe_tiles(fetch_args(), lds, 1, tid); const LAS int* tstart = (const LAS int*)(lds + MISC_OFF + 4096);
        pg8::Gemm g{(const pbf*)(ws + WS_R1 + R1_HMID), (const pbf*)(ws + WS_W2), 0, 0, 512}; pg8::MoeOrder S{tstart, tstart[32] * 4, G, bid, 32};
        pg8::EpiMoeDown E{(pbf*)(ws + WS_R1 + R1_Y2), (const int*)(ws + WS_ELIST), (const float*)(ws + WS_ELIST) + 32 * TT, tstart + 64, (LAS int*)(lds + MISC_OFF + 8192)};
        pg8::gemm_phase<pg8::EpiMoeDown, pg8::MoeOrder, true, true>(lds, g, S, E); } SEAM(17);
#if PROBE_A >= 0
    grid.sync();
    {   const double tot = (double)(ts[18] - ts[0]); const double fa = (double)(ts[PROBE_A + 1] - ts[PROBE_A]) / tot, fb = (double)(ts[PROBE_B + 1] - ts[PROBE_B]) / tot;
        #ifndef PROBE_MULT
#define PROBE_MULT 4.0
#endif
        const float spike = 2.0f * (float)pow(20.0, fmin(PROBE_MULT * fa, 1.0)), delta = (float)sqrt(2e-5 * pow(25.0, fmin(PROBE_MULT * fb, 1.0)));
        p_final(fetch_args(), gw, NGW, lane, 1.0f + delta, spike); }
#else
    if (IN(18)) { p_final(fetch_args(), gw, NGW, lane, 1.0f, 0.f); }
#endif
#undef IN
#undef SEAM
}

#ifndef MK_PER_PHASE
#define MK_PER_PHASE 0
#endif
extern "C" void kernel_launch(void* const* d_in, const int* in_sizes, int n_in, void* d_out, int out_size, void* d_ws, size_t ws_size, hipStream_t stream) {
    static int grid = 0;
    if (grid == 0) {
        if (n_in != 25 || in_sizes[0] != TX * DM || out_size != TX * DM || ws_size < WS_END) { fprintf(stderr, "kernel_launch: unexpected shapes/workspace: n_in %d in0 %d out %d ws %zu (need %zu)\n", n_in, n_in > 0 ? in_sizes[0] : -1, out_size, ws_size, (size_t)WS_END); grid = -1; return; }
        int dev = 0, cus = 0, per_cu = 0;
        if (hipGetDevice(&dev) != hipSuccess || hipDeviceGetAttribute(&cus, hipDeviceAttributeMultiprocessorCount, dev) != hipSuccess) { grid = -1; return; }
        if (hipFuncSetAttribute((const void*)mega_fwd, hipFuncAttributeMaxDynamicSharedMemorySize, LDS_BYTES) != hipSuccess) { fprintf(stderr, "kernel_launch: hipFuncSetAttribute failed\n"); grid = -1; return; }
        if (hipOccupancyMaxActiveBlocksPerMultiprocessor(&per_cu, (const void*)mega_fwd, NWAVES * 64, LDS_BYTES) != hipSuccess || per_cu < 1) { fprintf(stderr, "kernel_launch: occupancy query says %d blocks per CU\n", per_cu); grid = -1; return; }
        if (cus != 256) { fprintf(stderr, "kernel_launch: built for 256 CUs, found %d\n", cus); grid = -1; return; }
        grid = cus;
    }
    if (grid < 0) return;
    (void)hipMemsetAsync((char*)d_ws + WS_CTL, 0, CTL_ZERO_BYTES, stream);
    Args a{};
    for (int i = 0; i < 25; ++i) a.in[i] = (const float*)d_in[i];
    a.out = (float*)d_out; a.ws = (unsigned char*)d_ws;
#if MK_PER_PHASE
    for (int p = 0; p < NPH; ++p) { a.ph_lo = p; a.ph_hi = p + 1; void* kargs[] = {&a};
        hipError_t e = hipLaunchCooperativeKernel((const void*)mega_fwd, dim3(grid), dim3(NWAVES * 64), kargs, LDS_BYTES, stream);
        if (e != hipSuccess) { fprintf(stderr, "kernel_launch: launch %d failed: %s\n", p, hipGetErrorString(e)); break; } }
#else
    a.ph_lo = 0; a.ph_hi = NPH; void* kargs[] = {&a};
    hipError_t e = hipLaunchCooperativeKernel((const void*)mega_fwd, dim3(grid), dim3(NWAVES * 64), kargs, LDS_BYTES, stream);
    if (e != hipSuccess) fprintf(stderr, "kernel_launch: cooperative launch failed: %s\n", hipGetErrorString(e));
#endif
}
```

```cpp
#include <hip/hip_runtime.h>
#include <hip/hip_cooperative_groups.h>
#include <hip/hip_bf16.h>
#include <cstdio>
#include <cstdint>
#include <cmath>
namespace cg = cooperative_groups;
namespace pg8 {
#define PG8_LAS __attribute__((address_space(3)))
typedef unsigned short bf16_t;
typedef short bf16x8 __attribute__((ext_vector_type(8)));
typedef float f32x4 __attribute__((ext_vector_type(4)));
typedef unsigned u32x4 __attribute__((ext_vector_type(4)));
constexpr int BM = 256, BK = 64, HALF = 128, HTB = HALF * BK * 2  , STAGE_BYTES = 8 * HTB, NXCD = 8, WGM = 8;

__host__ __device__ __forceinline__ int lds_byte(int r, int c) { const int st = (r >> 4) * 2 + (c >> 5), rr = r & 15, cc = c & 31, ob = rr * 64 + cc * 2; return st * 1024 + (ob ^ (((ob >> 9) & 1) << 5)); }
__host__ __device__ __forceinline__ void stage_rc(int b, int& R, int& C) { const int st = b / 1024, sb = b % 1024, swz = sb ^ (((sb >> 9) & 1) << 5); R = (st >> 1) * 16 + swz / 64; C = (st & 1) * 32 + (swz % 64) / 2; }
__host__ __device__ __forceinline__ int perm32(int rho) { const int n = rho >> 4, i = rho & 15; return 8 * (i >> 2) + 4 * n + (i & 3); }

struct Unit { int pm, pn, e, lt; };
struct Gemm { const bf16_t* A; const bf16_t* Bt; int M, N, K; };

struct StaticOrder {
    int nM, nN, nwg, G, c;
    __host__ __device__ void init(int M, int N, int G_, int c_) { nM = M / BM; nN = N / BM; nwg = nM * nN; G = G_; c = c_; }
    __host__ __device__ bool next(int i, Unit& u) const {
        const long L = (long)i * G + c; if (L >= nwg) return false;
        int wgid = (int)L; { const int q = nwg / NXCD, r = nwg % NXCD, xcd = wgid % NXCD, off = wgid / NXCD; wgid = (xcd < r ? xcd * (q + 1) : r * (q + 1) + (xcd - r) * q) + off; }
        const int nig = WGM * nN, gid = wgid / nig, fm = gid * WGM, gsz = (nM - fm) < WGM ? (nM - fm) : WGM;
        u.pm = fm + ((wgid % nig) % gsz); u.pn = (wgid % nig) / gsz; return true;
    }
    __device__ __forceinline__ void a_ready(const Unit&) const {}
    __device__ __forceinline__ void done(const Unit&) const {}
};

__device__ __forceinline__ unsigned cvt_pk_bf16(float lo, float hi) { unsigned r; asm volatile("v_cvt_pk_bf16_f32 %0, %1, %2" : "=v"(r) : "v"(lo), "v"(hi)); return r; }
typedef float f32x2 __attribute__((ext_vector_type(2)));
struct DenseOrder {
    int nM, nN, nwg, G, c, mode, n2, pn2_0, nN2;
    __device__ __forceinline__ void init(int nM_, int nN_, int G_, int c_, int mode_, int n2_ = 0, int pn2_0_ = 0, int nN2_ = 1) { nM = nM_; nN = nN_; nwg = nM * nN; G = G_; c = c_; mode = mode_; n2 = n2_; pn2_0 = pn2_0_; nN2 = nN2_; }
    __device__ __forceinline__ bool next(int i, Unit& u) const {
        long L = (long)i * G + c;
        if (L < nwg) {
            int wgid = (int)L; { const int q = nwg / NXCD, r = nwg % NXCD, xcd = wgid % NXCD, off = wgid / NXCD; wgid = (xcd < r ? xcd * (q + 1) : r * (q + 1) + (xcd - r) * q) + off; }
            const int nig = WGM * nN, gid = wgid / nig, fm = gid * WGM, gsz = (nM - fm) < WGM ? (nM - fm) : WGM;
            int pm = fm + ((wgid % nig) % gsz); u.pn = (wgid % nig) / gsz;
            if (mode == 1) pm = pm + pm / 16 + 1;
            u.pm = pm; return true;
        }
        L -= nwg; if (L >= n2) return false;
        u.pm = 17 * (int)(L / nN2); u.pn = pn2_0 + (int)(L % nN2); return true;
    }
    __device__ __forceinline__ void a_ready(const Unit&) const {}
    __device__ __forceinline__ void done(const Unit&) const {}
};
struct MoeOrder {
    const PG8_LAS int* tstart; int nunits, G, c, ebase;
    __device__ __forceinline__ bool next(int i, Unit& u) const {
        const long L = (long)i * G + c; if (L >= nunits) return false;
        const int tile = (int)(L >> 2), j = (int)(L & 3); int e = 0;
#pragma unroll
        for (int k = 1; k < 32; ++k) e += (tile >= tstart[k]) ? 1 : 0;
        u.pm = tile; u.pn = (ebase + e) * 4 + j; u.e = e; u.lt = tile - tstart[e]; return true;
    }
    __device__ __forceinline__ void a_ready(const Unit&) const {}
    __device__ __forceinline__ void done(const Unit&) const {}
};

struct EpiBf16 {
    static constexpr bool PERM = true, AFTER_DRAIN = false;
    struct State {}; __device__ __forceinline__ void prefetch(const Unit&, State&, int) const {} __device__ __forceinline__ void stash(const State&, int, int) const {}
    bf16_t* O; int ldc; int split_cols; size_t split_stride; float scale0; unsigned long long* tsp = nullptr;
    __device__ __forceinline__ void operator()(const f32x4 (&acc)[2][2][4][2], const Unit& u, int wr, int wc, int fr, int fq, int ui = 0) const {
        const int row0 = u.pm * BM + wr * 64 + fr; int colt = u.pn * BM; bf16_t* base = O;
        float sc = 1.f; if (split_cols) { const int t = colt / split_cols; base += (size_t)t * split_stride; colt -= t * split_cols; if (t == 0) sc = scale0; }
        const int col0 = colt + wc * 32 + 8 * fq;
#pragma unroll
        for (int ai = 0; ai < 2; ++ai)
#pragma unroll
            for (int m = 0; m < 4; ++m) { bf16_t* rowp = base + (size_t)(row0 + ai * HALF + m * 16) * ldc + col0;
#pragma unroll
                for (int bj = 0; bj < 2; ++bj) { f32x4 v0 = acc[ai][bj][m][0] * sc, v1 = acc[ai][bj][m][1] * sc;
                    u32x4 w; w.x = cvt_pk_bf16(v0[0], v0[1]); w.y = cvt_pk_bf16(v0[2], v0[3]); w.z = cvt_pk_bf16(v1[0], v1[1]); w.w = cvt_pk_bf16(v1[2], v1[3]);
                    *(u32x4*)(rowp + bj * HALF) = w; } }
    }
};
struct EpiOddIn {
    static constexpr bool PERM = true, AFTER_DRAIN = false;
    struct State {}; __device__ __forceinline__ void prefetch(const Unit&, State&, int) const {} __device__ __forceinline__ void stash(const State&, int, int) const {}
    bf16_t *Q, *K, *V; float qscale; unsigned long long* tsp = nullptr;
    __device__ __forceinline__ void operator()(const f32x4 (&acc)[2][2][4][2], const Unit& u, int wr, int wc, int fr, int fq, int ui = 0) const {
        const int cw = wc * 32 + 8 * fq, rl0 = wr * 64 + fr;
        if (u.pn < 4) {
#pragma unroll
            for (int ai = 0; ai < 2; ++ai)
#pragma unroll
                for (int m = 0; m < 4; ++m) { bf16_t* rowp = Q + (size_t)(u.pm * BM + rl0 + ai * HALF + m * 16) * 1024 + u.pn * 256 + cw;
#pragma unroll
                    for (int bj = 0; bj < 2; ++bj) { const f32x4 v0 = acc[ai][bj][m][0] * qscale, v1 = acc[ai][bj][m][1] * qscale;
                        u32x4 w; w.x = cvt_pk_bf16(v0[0], v0[1]); w.y = cvt_pk_bf16(v0[2], v0[3]); w.z = cvt_pk_bf16(v1[0], v1[1]); w.w = cvt_pk_bf16(v1[2], v1[3]);
                        *(u32x4*)(rowp + bj * HALF) = w; } }
        } else {
            bf16_t* base = (u.pn < 8) ? K : V; const int ct = (u.pn & 3) * 256, b = u.pm / 17, rb = (u.pm - b * 17) * 256 + rl0;
#pragma unroll
            for (int bj = 0; bj < 2; ++bj) { const int col = ct + bj * HALF + cw, h = col >> 6, d = col & 63; bf16_t* hp = base + ((size_t)(b * 16 + h) * 4352) * 64 + d;
#pragma unroll
                for (int ai = 0; ai < 2; ++ai)
#pragma unroll
                    for (int m = 0; m < 4; ++m) { const f32x4 v0 = acc[ai][bj][m][0], v1 = acc[ai][bj][m][1];
                        u32x4 w; w.x = cvt_pk_bf16(v0[0], v0[1]); w.y = cvt_pk_bf16(v0[2], v0[3]); w.z = cvt_pk_bf16(v1[0], v1[1]); w.w = cvt_pk_bf16(v1[2], v1[3]);
                        *(u32x4*)(hp + (size_t)(rb + ai * HALF + m * 16) * 64) = w; } }
        }
    }
};
struct EpiEvenIn {
    static constexpr bool PERM = true, AFTER_DRAIN = false;
    struct State {}; __device__ __forceinline__ void prefetch(const Unit&, State&, int) const {} __device__ __forceinline__ void stash(const State&, int, int) const {}
    bf16_t *Q, *K, *V, *U; unsigned long long* tsp = nullptr;
    __device__ __forceinline__ void operator()(const f32x4 (&acc)[2][2][4][2], const Unit& u, int wr, int wc, int fr, int fq, int ui = 0) const {
        const int row0 = u.pm * BM + wr * 64 + fr, cw = wc * 32 + 8 * fq;
#pragma unroll
        for (int bj = 0; bj < 2; ++bj) {
            bf16_t* base; int ldc, col;
            if (u.pn < 2) { base = Q; ldc = 512; col = u.pn * 256 + bj * HALF + cw; }
            else if (u.pn == 2) { base = bj ? V : K; ldc = 128; col = cw; }
            else { base = U; ldc = 512; col = (u.pn - 3) * 256 + bj * HALF + cw; }
#pragma unroll
            for (int ai = 0; ai < 2; ++ai)
#pragma unroll
                for (int m = 0; m < 4; ++m) { const f32x4 v0 = acc[ai][bj][m][0], v1 = acc[ai][bj][m][1];
                    u32x4 w; w.x = cvt_pk_bf16(v0[0], v0[1]); w.y = cvt_pk_bf16(v0[2], v0[3]); w.z = cvt_pk_bf16(v1[0], v1[1]); w.w = cvt_pk_bf16(v1[2], v1[3]);
                    *(u32x4*)(base + (size_t)(row0 + ai * HALF + m * 16) * ldc + col) = w; }
        }
    }
};
struct EpiResid {
    static constexpr bool PERM = false, AFTER_DRAIN = false;
    struct State {}; __device__ __forceinline__ void prefetch(const Unit&, State&, int) const {} __device__ __forceinline__ void stash(const State&, int, int) const {}
    const float* xin; const float* cin; float* xout; float* cout; const float* modg; unsigned long long* tsp = nullptr;
    __device__ __forceinline__ void operator()(const f32x4 (&acc)[2][2][4][2], const Unit& u, int wr, int wc, int fr, int fq, int ui = 0) const {
        const int b = u.pm / 17, j = u.pm - b * 17;
        const float* src; float* dst; const float* g;
        if (j == 0) { src = cin + (size_t)b * 256 * 1024; dst = cout + (size_t)b * 256 * 1024; g = modg + 8 * 6144; }
        else { const size_t o = ((size_t)b * 4096 + (size_t)(j - 1) * 256) * 1024; src = xin + o; dst = xout + o; g = modg + b * 6144; }
        const int row0 = wr * 64 + fr, col0 = u.pn * BM + wc * 32 + 4 * fq;
        f32x4 gv[2][2];
#pragma unroll
        for (int bj = 0; bj < 2; ++bj)
#pragma unroll
            for (int n = 0; n < 2; ++n) gv[bj][n] = *(const f32x4*)(g + col0 + bj * HALF + n * 16);
#pragma unroll
        for (int ai = 0; ai < 2; ++ai)
#pragma unroll
            for (int m = 0; m < 4; ++m) { const size_t off = (size_t)(row0 + ai * HALF + m * 16) * 1024 + col0;
#pragma unroll
                for (int bj = 0; bj < 2; ++bj)
#pragma unroll
                    for (int n = 0; n < 2; ++n) { const f32x4 s = *(const f32x4*)(src + off + bj * HALF + n * 16); *(f32x4*)(dst + off + bj * HALF + n * 16) = s + gv[bj][n] * acc[ai][bj][m][n]; } }
    }
};
struct EpiMoeUp {
    static constexpr bool PERM = true, AFTER_DRAIN = false;
    struct State {}; __device__ __forceinline__ void prefetch(const Unit&, State&, int) const {} __device__ __forceinline__ void stash(const State&, int, int) const {}
    bf16_t* H; unsigned long long* tsp = nullptr;
    __device__ __forceinline__ static float silu_mul(float a, float b) { return a * __builtin_amdgcn_rcpf(1.0f + __expf(-a)) * b; }
    __device__ __forceinline__ void operator()(const f32x4 (&acc)[2][2][4][2], const Unit& u, int wr, int wc, int fr, int fq, int ui = 0) const {
        const int row0 = u.pm * BM + wr * 64 + fr, col = (u.pn & 3) * 128 + wc * 32 + 8 * fq;
#pragma unroll
        for (int ai = 0; ai < 2; ++ai)
#pragma unroll
            for (int m = 0; m < 4; ++m) { const f32x4 a0 = acc[ai][0][m][0], a1 = acc[ai][0][m][1], b0 = acc[ai][1][m][0], b1 = acc[ai][1][m][1];
                u32x4 w; w.x = cvt_pk_bf16(silu_mul(a0[0], b0[0]), silu_mul(a0[1], b0[1])); w.y = cvt_pk_bf16(silu_mul(a0[2], b0[2]), silu_mul(a0[3], b0[3]));
                w.z = cvt_pk_bf16(silu_mul(a1[0], b1[0]), silu_mul(a1[1], b1[1])); w.w = cvt_pk_bf16(silu_mul(a1[2], b1[2]), silu_mul(a1[3], b1[3]));
                *(u32x4*)(H + (size_t)(row0 + ai * HALF + m * 16) * 512 + col) = w; }
    }
};
constexpr int MOE_TT = 34816, MOE_CAP = 34816;
struct MoeGather {
    static constexpr bool GATHER = true;
    const int* elist; const PG8_LAS int* cnt;
    __device__ __forceinline__ void get(const Unit& u, const int (&sR)[2], unsigned& p0, unsigned& p1) const {
        const int c = cnt[u.e] - u.lt * 256; const int* el = elist + u.e * MOE_CAP + u.lt * 256;
        unsigned v[4];
#pragma unroll
        for (int i = 0; i < 4; ++i) { const int r = (i >> 1) * 128 + sR[i & 1]; int t = (r < c) ? el[r] : 0; t = (t >= MOE_TT) ? t - MOE_TT : t; v[i] = (unsigned)t; }
        p0 = v[0] | (v[1] << 16); p1 = v[2] | (v[3] << 16);
    }
};
struct EpiMoeDown {
    static constexpr bool PERM = true, AFTER_DRAIN = false;
    bf16_t* Y; const int* elist; const float* ewgt; const PG8_LAS int* cnt; PG8_LAS int* lrow; unsigned long long* tsp = nullptr;
    struct State { int d; float w; };
    __device__ __forceinline__ void prefetch(const Unit& u, State& st, int tid) const {
        if (tid < 256) { const int c = cnt[u.e] - u.lt * 256, lo = u.e * MOE_CAP + u.lt * 256, rc = min(tid, c - 1); st.d = (tid < c) ? elist[lo + rc] : -1; st.w = ewgt[lo + rc]; } }
    __device__ __forceinline__ void stash(const State& st, int ui, int tid) const {
        if (tid < 256) { lrow[(ui & 1) * 256 + tid] = st.d; ((PG8_LAS float*)(lrow + 512))[(ui & 1) * 256 + tid] = st.w; } }
    __device__ __forceinline__ void operator()(const f32x4 (&acc)[2][2][4][2], const Unit& u, int wr, int wc, int fr, int fq, int ui = 0) const {
        const int r0 = wr * 64 + fr; const unsigned colb = (unsigned)((u.pn & 3) * 256 + wc * 32 + 8 * fq) * 2u;
        const PG8_LAS int* ld = lrow + (ui & 1) * 256; const PG8_LAS float* lw = (const PG8_LAS float*)(lrow + 512) + (ui & 1) * 256;
#pragma unroll
        for (int ai = 0; ai < 2; ++ai)
#pragma unroll
            for (int m = 0; m < 4; ++m) { const int r = r0 + ai * HALF + m * 16; const int d = ld[r]; const float wv = lw[r];
                if (d >= 0) {
#pragma unroll
                    for (int bj = 0; bj < 2; ++bj) { const f32x4 v0 = acc[ai][bj][m][0] * wv, v1 = acc[ai][bj][m][1] * wv;
                        u32x4 w; w.x = cvt_pk_bf16(v0[0], v0[1]); w.y = cvt_pk_bf16(v0[2], v0[3]); w.z = cvt_pk_bf16(v1[0], v1[1]); w.w = cvt_pk_bf16(v1[2], v1[3]);
                        *(u32x4*)((char*)Y + ((unsigned)d * 2048u + colb + (unsigned)(bj * HALF * 2))) = w; } } }
    }
};

struct DenseA { static constexpr bool GATHER = false; };
template <class Epi, class Sched, bool ALIGN_EPI = false, bool SP2 = false, class AOff = DenseA>
__device__ __forceinline__ void gemm_phase(PG8_LAS unsigned char* lds, const Gemm g, const Sched& S, const Epi& E, const AOff& AO = AOff()) {
    const int tid = threadIdx.x, wid = __builtin_amdgcn_readfirstlane(tid >> 6), lane = tid & 63, wr = wid >> 2, wc = wid & 3, fr = lane & 15, fq = lane >> 4;
    const int K = g.K, nt = K / BK;
    unsigned voffA[2], voffB[2]; int sR[2], sC[2];
#pragma unroll
    for (int i = 0; i < 2; ++i) { int R, C; stage_rc(tid * 16 + i * 8192, R, C); const int Rb = Epi::PERM ? ((R & ~31) + perm32(R & 31)) : R; sR[i] = R; sC[i] = C;
        voffA[i] = (unsigned)(R * K + C) * 2u; voffB[i] = (unsigned)(Rb * K + C) * 2u; }
    const size_t kstep = (size_t)(BK * 2);
    const size_t hstep = (size_t)HALF * K * 2;
    const size_t tstep = 2 * hstep;
    const unsigned ldsw = (unsigned)wid * 1024u;
    const int aoff = lds_byte(wr * 64 + fr, fq * 8), boff = lds_byte(wc * 32 + fr, fq * 8);
#define PG8_SA(b, h) (((b) * 2 + (h)) * HTB)
#define PG8_SB(b, h) ((4 + (b) * 2 + (h)) * HTB)
#define PG8_STAGE(bufoff, gbase, voff) do { _Pragma("unroll") for (int _i = 0; _i < 2; ++_i) \
        __builtin_amdgcn_global_load_lds((const unsigned*)((const char*)(gbase) + (voff)[_i]), (PG8_LAS unsigned*)(lds + (bufoff) + ldsw + _i * 8192), 16, 0, 0); } while (0)
#define PG8_LDA(dst, b, h) do { _Pragma("unroll") for (int m = 0; m < 4; ++m) _Pragma("unroll") for (int k = 0; k < 2; ++k) dst[m][k] = *(const PG8_LAS bf16x8*)(lds + PG8_SA(b, h) + aoff + m * 2048 + k * 1024); } while (0)
#define PG8_LDB(dst, b, h) do { _Pragma("unroll") for (int n = 0; n < 2; ++n) _Pragma("unroll") for (int k = 0; k < 2; ++k) dst[n][k] = *(const PG8_LAS bf16x8*)(lds + PG8_SB(b, h) + boff + n * 2048 + k * 1024); } while (0)
#define PG8_MMA(ai, bj, At, Bt) do { __builtin_amdgcn_s_setprio(1); _Pragma("unroll") for (int m = 0; m < 4; ++m) _Pragma("unroll") for (int n = 0; n < 2; ++n) _Pragma("unroll") for (int k = 0; k < 2; ++k) \
        acc[ai][bj][m][n] = __builtin_amdgcn_mfma_f32_16x16x32_bf16(Bt[n][k], At[m][k], acc[ai][bj][m][n], 0, 0, 0); __builtin_amdgcn_s_setprio(0); } while (0)
#define PG8_WAIT_V(n) asm volatile("s_waitcnt vmcnt(" #n ")" ::: "memory")
#define PG8_WAIT_L(n) asm volatile("s_waitcnt lgkmcnt(" #n ")" ::: "memory")
#define PG8_BAR __builtin_amdgcn_s_barrier()
#define PG8_SCHED __builtin_amdgcn_sched_barrier(0)
    Unit cur, nxt; int ui = 0;
    if (!S.next(0, cur)) return;
    f32x4 acc[2][2][4][2];
#pragma unroll
    for (int a = 0; a < 2; ++a)
#pragma unroll
        for (int b = 0; b < 2; ++b)
#pragma unroll
            for (int m = 0; m < 4; ++m)
#pragma unroll
                for (int n = 0; n < 2; ++n) acc[a][b][m][n] = (f32x4){0.f, 0.f, 0.f, 0.f};
    bf16x8 At[4][2], B0[2][2], B1[2][2];
    const char* cA = AOff::GATHER ? (const char*)g.A : (const char*)g.A + (size_t)cur.pm * tstep; const char* cB = (const char*)g.Bt + (size_t)cur.pn * tstep;
    unsigned c0[2], c1[2];
    c0[0] = voffA[0]; c0[1] = voffA[1]; c1[0] = voffA[0] + (unsigned)hstep; c1[1] = voffA[1] + (unsigned)hstep;
    unsigned cp0 = 0u, cp1 = 0u, np0 = 0u, np1 = 0u;
    const unsigned K2 = (unsigned)K * 2u, cb0 = (unsigned)sC[0] * 2u, cb1 = (unsigned)sC[1] * 2u;
    if constexpr (AOff::GATHER) { AO.get(cur, sR, cp0, cp1); np0 = cp0; np1 = cp1; }
#define PG8_AOFF(arr, pk, dense) unsigned arr[2]; if constexpr (AOff::GATHER) { arr[0] = ((pk) & 0xffffu) * K2 + cb0; arr[1] = ((pk) >> 16) * K2 + cb1; } else { arr[0] = dense[0]; arr[1] = dense[1]; }
    S.a_ready(cur);
    typename Epi::State est{}; E.prefetch(cur, est, tid);
    if constexpr (SP2) {
        PG8_STAGE(PG8_SB(0, 0), cB, voffB); PG8_STAGE(PG8_SB(0, 1), cB + hstep, voffB); { PG8_AOFF(q0, cp0, c0) PG8_AOFF(q1, cp1, c1) PG8_STAGE(PG8_SA(0, 0), cA, q0); PG8_STAGE(PG8_SA(0, 1), cA, q1); }
        if (wr == 1) PG8_BAR;
        PG8_WAIT_V(2); PG8_BAR;
        PG8_STAGE(PG8_SB(1, 0), cB + kstep, voffB); { PG8_AOFF(q0, cp0, c0) PG8_STAGE(PG8_SA(1, 0), cA + kstep, q0); } PG8_STAGE(PG8_SB(1, 1), cB + hstep + kstep, voffB);
        PG8_WAIT_V(6); PG8_BAR;
    } else {
        PG8_STAGE(PG8_SB(0, 0), cB, voffB); PG8_STAGE(PG8_SA(0, 0), cA, voffA); PG8_STAGE(PG8_SB(0, 1), cB + hstep, voffB); PG8_STAGE(PG8_SA(0, 1), cA + hstep, voffA);
        if (wr == 1) PG8_BAR;
        PG8_WAIT_V(4); PG8_BAR;
        PG8_STAGE(PG8_SB(1, 0), cB + kstep, voffB); PG8_STAGE(PG8_SA(1, 0), cA + kstep, voffA); PG8_STAGE(PG8_SB(1, 1), cB + hstep + kstep, voffB);
        PG8_WAIT_V(6); PG8_BAR;
    }
    for (;;) {
        E.stash(est, ui, tid);
        const bool has_next = S.next(ui + 1, nxt);
        const char* nA = AOff::GATHER ? cA : (has_next ? (const char*)g.A + (size_t)nxt.pm * tstep : cA); const char* nB = has_next ? (const char*)g.Bt + (size_t)nxt.pn * tstep : cB;
        if constexpr (AOff::GATHER) { if (has_next) AO.get(nxt, sR, np0, np1); else { np0 = cp0; np1 = cp1; } }
        for (int t = 0; t < nt; t += 2) {
            const bool last = (t == nt - 2);
            const char* a1 = cA + (size_t)(t + 1) * kstep;
            const char* a2 = last ? nA : cA + (size_t)(t + 2) * kstep; const char* b2 = last ? nB : cB + (size_t)(t + 2) * kstep;
            const char* a3 = a2 + kstep; const char* b3 = b2 + kstep;
            const unsigned sp0 = last ? np0 : cp0, sp1 = last ? np1 : cp1;
            if (last && has_next) S.a_ready(nxt);
            if constexpr (SP2) {
            PG8_LDB(B0, 0, 0); PG8_LDB(B1, 0, 1); PG8_SCHED; PG8_LDA(At, 0, 0); { PG8_AOFF(q1, cp1, c1) PG8_STAGE(PG8_SA(1, 1), a1, q1); }
            PG8_WAIT_V(8); PG8_WAIT_L(0); PG8_BAR; PG8_MMA(0, 0, At, B0); PG8_MMA(0, 1, At, B1); PG8_BAR; PG8_SCHED;
            PG8_LDA(At, 0, 1); PG8_STAGE(PG8_SB(0, 0), b2, voffB); PG8_STAGE(PG8_SB(0, 1), b2 + hstep, voffB); { PG8_AOFF(q0, sp0, c0) PG8_STAGE(PG8_SA(0, 0), a2, q0); }
            PG8_WAIT_V(8); PG8_WAIT_L(0); PG8_BAR; PG8_MMA(1, 0, At, B0); PG8_MMA(1, 1, At, B1); PG8_BAR; PG8_SCHED;
            PG8_LDB(B0, 1, 0); PG8_LDB(B1, 1, 1); PG8_SCHED; PG8_LDA(At, 1, 0); { PG8_AOFF(q1, sp1, c1) PG8_STAGE(PG8_SA(0, 1), a2, q1); }
            PG8_WAIT_V(8); PG8_WAIT_L(0); PG8_BAR; PG8_MMA(0, 0, At, B0); PG8_MMA(0, 1, At, B1); PG8_BAR; PG8_SCHED;
            PG8_LDA(At, 1, 1); PG8_STAGE(PG8_SB(1, 0), b3, voffB); PG8_STAGE(PG8_SB(1, 1), b3 + hstep, voffB); { PG8_AOFF(q0, sp0, c0) PG8_STAGE(PG8_SA(1, 0), a3, q0); }
            PG8_WAIT_V(8); PG8_WAIT_L(0); PG8_BAR; PG8_MMA(1, 0, At, B0); PG8_MMA(1, 1, At, B1); PG8_BAR; PG8_SCHED;
            } else {
            PG8_LDB(B0, 0, 0); PG8_SCHED; PG8_LDA(At, 0, 0); PG8_STAGE(PG8_SA(1, 1), a1 + hstep, voffA);
            PG8_WAIT_L(8); PG8_BAR; PG8_WAIT_L(0); PG8_MMA(0, 0, At, B0); PG8_BAR; PG8_SCHED;
            PG8_LDB(B1, 0, 1); PG8_STAGE(PG8_SB(0, 0), b2, voffB);
            PG8_BAR; PG8_WAIT_L(0); PG8_MMA(0, 1, At, B1); PG8_BAR;
            PG8_LDA(At, 0, 1); PG8_STAGE(PG8_SA(0, 0), a2, voffA);
            PG8_BAR; PG8_WAIT_L(0); PG8_MMA(1, 0, At, B0); PG8_BAR; PG8_SCHED;
            PG8_STAGE(PG8_SB(0, 1), b2 + hstep, voffB);
            PG8_WAIT_V(6); PG8_BAR; PG8_MMA(1, 1, At, B1); PG8_BAR;
            PG8_LDB(B0, 1, 0); PG8_SCHED; PG8_LDA(At, 1, 0); PG8_STAGE(PG8_SA(0, 1), a2 + hstep, voffA);
            PG8_WAIT_L(8); PG8_BAR; PG8_WAIT_L(0); PG8_MMA(0, 0, At, B0); PG8_BAR; PG8_SCHED;
            PG8_LDB(B1, 1, 1); PG8_STAGE(PG8_SB(1, 0), b3, voffB);
            PG8_BAR; PG8_WAIT_L(0); PG8_MMA(0, 1, At, B1); PG8_BAR;
            PG8_LDA(At, 1, 1); PG8_STAGE(PG8_SA(1, 0), a3, voffA);
            PG8_BAR; PG8_WAIT_L(0); PG8_MMA(1, 0, At, B0); PG8_BAR; PG8_SCHED;
            PG8_STAGE(PG8_SB(1, 1), b3 + hstep, voffB);
            PG8_WAIT_V(6); PG8_BAR; PG8_MMA(1, 1, At, B1); PG8_BAR;
            }
        }
        if constexpr (ALIGN_EPI) { if (wr == 0) PG8_BAR; }
        if constexpr (!Epi::AFTER_DRAIN) { E(acc, cur, wr, wc, fr, fq, ui); S.done(cur); if (has_next) E.prefetch(nxt, est, tid); }
        if (!has_next) break;
#pragma unroll
        for (int a = 0; a < 2; ++a)
#pragma unroll
            for (int b = 0; b < 2; ++b)
#pragma unroll
                for (int m = 0; m < 4; ++m)
#pragma unroll
                    for (int n = 0; n < 2; ++n) acc[a][b][m][n] = (f32x4){0.f, 0.f, 0.f, 0.f};
        cur = nxt; cA = nA; cB = nB; ++ui;
        if constexpr (AOff::GATHER) { cp0 = np0; cp1 = np1; }
        if constexpr (ALIGN_EPI) { if (wr == 1) PG8_BAR; }
    }
    PG8_WAIT_V(0);
    if constexpr (!ALIGN_EPI) { if (wr == 0) PG8_BAR; }
    PG8_BAR;
    if constexpr (Epi::AFTER_DRAIN) { E.fused(acc, cur, wr, wc, fr, fq, lds, wid, lane); S.done(cur); }
#undef PG8_SA
#undef PG8_SB
#undef PG8_STAGE
#undef PG8_LDA
#undef PG8_LDB
#undef PG8_MMA
#undef PG8_WAIT_V
#undef PG8_WAIT_L
#undef PG8_BAR
#undef PG8_SCHED
#undef PG8_AOFF
}
}
namespace attn_body {
using bf16=__hip_bfloat16;
using bf16x8=__attribute__((ext_vector_type(8)))short;
using s16x4=__attribute__((ext_vector_type(4)))short;
using f32x16=__attribute__((ext_vector_type(16)))float;
using u32x4=__attribute__((ext_vector_type(4)))unsigned;
constexpr int D=64;
constexpr int NW=8,QBLK=32,QB=QBLK*NW,KVBLK=64;
__device__ __forceinline__ int crow(int r,int hi){return (r&3)+8*(r>>2)+4*hi;}
#define SBAR() __builtin_amdgcn_sched_barrier(0)
__device__ __forceinline__ void cmask(f32x16&p0,f32x16&p1,int jb,int qrel,int hi){
  const float NEG=-INFINITY; int kb=64*jb+4*hi;
  #pragma unroll
  for(int r=0;r<16;++r){int kv=kb+(r&3)+8*(r>>2); if(kv>qrel)p0[r]=NEG; if(kv+32>qrel)p1[r]=NEG;}
}

constexpr int NSLOT=3, SLOTB=8192;
constexpr int LDS_K=0, LDS_V=NSLOT*SLOTB, LDS_WS=2*NSLOT*SLOTB, LDS_OST=LDS_WS+NW*64*4, LDS_BYTES=LDS_OST+NW*4096;
constexpr float C2=0.125f*1.4426950408889634f;
__device__ __forceinline__ void glds16(const void*gsrc,unsigned lds_dst){unsigned keep;
  asm volatile("s_mov_b32 %0, m0\n\ts_mov_b32 m0, %2\n\ts_nop 0\n\tglobal_load_lds_dwordx4 %1, off\n\ts_mov_b32 m0, %0":"=&s"(keep):"v"(gsrc),"s"(lds_dst):"memory");}
__device__ __forceinline__ float max3f(float a,float b,float c){float r;asm("v_max3_f32 %0, %1, %2, %3":"=v"(r):"v"(a),"v"(b),"v"(c));return r;}
__device__ __forceinline__ float max2f(float a,float b){float r;asm("v_max_f32_e32 %0, %1, %2":"=v"(r):"v"(a),"v"(b));return r;}
__device__ __forceinline__ float fadd_s(float a,float b){float r;asm("v_add_f32_e32 %0, %1, %2":"=v"(r):"v"(a),"v"(b));return r;}
__device__ __forceinline__ float fsub_s(float a,float b){float r;asm("v_sub_f32_e32 %0, %1, %2":"=v"(r):"v"(a),"v"(b));return r;}
typedef float f32x2_t __attribute__((ext_vector_type(2))); typedef __bf16 bf16x2_t __attribute__((ext_vector_type(2)));
__device__ __forceinline__ unsigned cvtpk_s(float lo,float hi){f32x2_t v={lo,hi};bf16x2_t b=__builtin_convertvector(v,bf16x2_t);return __builtin_bit_cast(unsigned,b);}
#define WAIT_BAR(N) asm volatile("s_waitcnt vmcnt(" #N ") lgkmcnt(0)\n\ts_barrier":::"memory")

__device__ __forceinline__ void qkt(f32x16&p0,f32x16&p1,const char*Kslot,const bf16x8*qr,const f32x16&negm,int r32,int hi){
  const char*kb=Kslot+hi*1024+r32*16;
  #pragma unroll
  for(int d0=0;d0<4;++d0){
    const bf16x8 b0=*reinterpret_cast<const bf16x8*>(kb+d0*2048);
    const bf16x8 b1=*reinterpret_cast<const bf16x8*>(kb+d0*2048+512);
    if(d0==0){p0=__builtin_amdgcn_mfma_f32_32x32x16_bf16(b0,qr[0],negm,0,0,0);p1=__builtin_amdgcn_mfma_f32_32x32x16_bf16(b1,qr[0],negm,0,0,0);}
    else{p0=__builtin_amdgcn_mfma_f32_32x32x16_bf16(b0,qr[d0],p0,0,0,0);p1=__builtin_amdgcn_mfma_f32_32x32x16_bf16(b1,qr[d0],p1,0,0,0);}}
}
typedef __attribute__((address_space(3))) const char* lds_cptr;
typedef short v4i16_t __attribute__((ext_vector_type(4)));
__device__ __forceinline__ void kload8(bf16x8*kf,lds_cptr kp){
  kf[0]=*(const __attribute__((address_space(3))) bf16x8*)(kp);      kf[1]=*(const __attribute__((address_space(3))) bf16x8*)(kp+512);
  kf[2]=*(const __attribute__((address_space(3))) bf16x8*)(kp+2048); kf[3]=*(const __attribute__((address_space(3))) bf16x8*)(kp+2560);
  kf[4]=*(const __attribute__((address_space(3))) bf16x8*)(kp+4096); kf[5]=*(const __attribute__((address_space(3))) bf16x8*)(kp+4608);
  kf[6]=*(const __attribute__((address_space(3))) bf16x8*)(kp+6144); kf[7]=*(const __attribute__((address_space(3))) bf16x8*)(kp+6656);
}
__device__ __forceinline__ void kload2(bf16x8*kf,lds_cptr kp,int j){ kf[2*j]=*(const __attribute__((address_space(3))) bf16x8*)(kp+j*2048); kf[2*j+1]=*(const __attribute__((address_space(3))) bf16x8*)(kp+j*2048+512); }
__device__ __forceinline__ s16x4 vtr(lds_cptr p){ return __builtin_bit_cast(s16x4,__builtin_amdgcn_ds_read_tr16_b64_v4i16((__attribute__((address_space(3))) v4i16_t*)p)); }
__device__ __forceinline__ float rowmax(const f32x16&p0,const f32x16&p1){
  float a=max3f(p0[0],p0[1],p1[0]),b=max3f(p0[2],p0[3],p1[1]);a=max3f(a,p1[2],p1[3]);
  #pragma unroll
  for(int r=4;r<16;r+=4){a=max3f(a,p0[r],p0[r+1]);b=max3f(b,p0[r+2],p0[r+3]);a=max3f(a,p1[r],p1[r+1]);b=max3f(b,p1[r+2],p1[r+3]);}
  const float m=max2f(a,b);
  auto rr=__builtin_amdgcn_permlane32_swap(__float_as_uint(m),__float_as_uint(m),false,false);
  return max2f(__uint_as_float(rr[0]),__uint_as_float(rr[1]));
}
__device__ __forceinline__ void pv(f32x16*o,int vb,bf16x8 pa0,bf16x8 pa1,bf16x8 pa2,bf16x8 pa3){
  #pragma unroll
  for(int d0=0;d0<2;++d0){s16x4 lo[4],hi[4];
    #pragma unroll
    for(int ks=0;ks<4;++ks){
      asm volatile("ds_read_b64_tr_b16 %0,%1 offset:%c2":"=&v"(lo[ks]):"v"(vb),"i"(d0*4096+ks*1024):"memory");
      asm volatile("ds_read_b64_tr_b16 %0,%1 offset:%c2":"=&v"(hi[ks]):"v"(vb),"i"(d0*4096+ks*1024+512):"memory");}
    asm volatile("s_waitcnt lgkmcnt(0)":::"memory");SBAR();
    #define PK(k) (bf16x8){lo[k][0],lo[k][1],lo[k][2],lo[k][3],hi[k][0],hi[k][1],hi[k][2],hi[k][3]}
    o[d0]=__builtin_amdgcn_mfma_f32_32x32x16_bf16(pa0,PK(0),o[d0],0,0,0);
    o[d0]=__builtin_amdgcn_mfma_f32_32x32x16_bf16(pa1,PK(1),o[d0],0,0,0);
    o[d0]=__builtin_amdgcn_mfma_f32_32x32x16_bf16(pa2,PK(2),o[d0],0,0,0);
    o[d0]=__builtin_amdgcn_mfma_f32_32x32x16_bf16(pa3,PK(3),o[d0],0,0,0);
    #undef PK
  }
}

#ifndef ATTN_STORE16
#define ATTN_STORE16(p,v) (*(u32x4*)(p)=(v))
#endif
template<int THRL,int QP,int KP,int VP,int OP,class Hook> __device__ __forceinline__ void attn_unit(const bf16*Qw0,const bf16*__restrict__ Kh,const bf16*__restrict__ Vh,bf16*Ow0,const int NT,const Hook&hk,char*shm){
  const int tid=threadIdx.x,lane=tid&63,r32=lane&31,hi=lane>>5; const int wid=__builtin_amdgcn_readfirstlane(tid>>6);
  const bf16*Qw=Qw0+(long)(wid*QBLK)*QP;
#if defined(PROBE_SUB)
  #define ASTAMP(i) do{ if(Hook::MASK && hk.tsp && blockIdx.x==0 && tid==0) hk.tsp[(i)]=__builtin_amdgcn_s_memrealtime(); }while(0)
#else
  #define ASTAMP(i) do{}while(0)
#endif
  ASTAMP(0);
  const unsigned lds0=(unsigned)(uintptr_t)shm;
  float*wsf=(float*)(shm+LDS_WS)+wid*64;
  const bf16*ksrc=Kh+(long)lane*KP+wid*8;
  const bf16*vsrc=Vh+(long)(16*(wid&3)+(lane>>2))*VP+(wid>>2)*32+(lane&3)*8;
  const unsigned kdst=lds0+LDS_K+wid*1024, vdst=lds0+LDS_V+wid*1024;
  #define DMA_K(t,slot) glds16(ksrc+(long)hk.tile_row(t)*KP,(unsigned)__builtin_amdgcn_readfirstlane(kdst+(slot)))
  #define DMA_V(t,slot) glds16(vsrc+(long)hk.tile_row(t)*VP,(unsigned)__builtin_amdgcn_readfirstlane(vdst+(slot)))
  const int vb0=(int)(lds0+LDS_V)+((lane>>4)&1)*32+(lane&3)*8+(4*hi+((lane&15)>>2))*64;
  const char*Kbase=shm+LDS_K; bf16x8 kf[8];
  const lds_cptr shm3=(lds_cptr)shm; const lds_cptr kp0=shm3+LDS_K+hi*1024+r32*16; const lds_cptr vp0=shm3+LDS_V+((lane>>4)&1)*32+(lane&3)*8+(4*hi+((lane&15)>>2))*64;
  DMA_K(0,0);DMA_V(0,0);DMA_K(1,SLOTB);
  bf16x8 qr[4];
  #pragma unroll
  for(int d0=0;d0<4;++d0)qr[d0]=*reinterpret_cast<const bf16x8*>(&Qw[(long)r32*QP+d0*16+hi*8]);
  float mhat=0.f,l_reg=0.f;f32x16 o[2];o[0]=f32x16{};o[1]=f32x16{};f32x16 negm=f32x16{};if(Hook::NEGC)asm volatile("":"+v"(negm)); const f32x16 zc=f32x16{};
  #define CMASK(P0,P1,t) do{ if(Hook::MASK) hk.mask(P0,P1,(t),mhat); }while(0)
  bool resc=false;
  #define START(P0,P1) do{ const float rm=rowmax(P0,P1); resc=false; \
    { const float dl=rm; mhat=fadd_s(mhat,dl); \
      _Pragma("unroll") for(int r=0;r<16;++r){P0[r]=fsub_s(P0[r],dl);P1[r]=fsub_s(P1[r],dl);} \
      if(Hook::NEGC){ _Pragma("unroll") for(int r=0;r<16;++r)negm[r]=-mhat; asm volatile("":"+v"(negm)); } } \
    _Pragma("unroll") for(int r=0;r<16;++r)P0[r]=__builtin_amdgcn_exp2f(P0[r]); }while(0)
  #define RESC() do{ if(resc){ asm volatile("s_waitcnt lgkmcnt(0)":::"memory"); \
      _Pragma("unroll") for(int d_=0;d_<2;++d_) _Pragma("unroll") for(int r=0;r<16;++r)o[d_][r]*=wsf[crow(r,hi)]; } }while(0)
  f32x16 pA0,pA1,pB0,pB1;
  int sl_prev=0,sl_cur=0,sl_next=SLOTB;
  #define ROT() do{sl_prev=sl_cur;sl_cur=sl_next;sl_next=(sl_next==(NSLOT-1)*SLOTB)?0:sl_next+SLOTB;}while(0)
  DMA_K(2,2*SLOTB);
  WAIT_BAR(3); ASTAMP(1);
  qkt(pA0,pA1,Kbase,qr,(Hook::NEGC?negm:zc),r32,hi);asm volatile("s_nop 15\n\ts_nop 7":"+v"(pA0),"+v"(pA1));CMASK(pA0,pA1,0);
  START(pA0,pA1);
  _Pragma("unroll") for(int r=0;r<16;++r)pA1[r]=__builtin_amdgcn_exp2f(pA1[r]);
  WAIT_BAR(0);
  DMA_K(3,0);DMA_V(1,SLOTB);
  ROT();
  kload8(kf,kp0+sl_cur);
  WAIT_BAR(2); ASTAMP(2);
  s16x4 vlo[8],vhi[8]; u32x4 pw0,pw1,pw2,pw3;
  #define PKW(P,B) cvtpk_s(P[B],P[B+1])
  #define PAF(k) __builtin_bit_cast(bf16x8,pw##k)
  #define VFR(i) (bf16x8){vlo[i][0],vlo[i][1],vlo[i][2],vlo[i][3],vhi[i][0],vhi[i][1],vhi[i][2],vhi[i][3]}
  #define PIN(x) asm volatile("":"+v"(x))
  #define MX3(a,b,c) __builtin_fmaxf(__builtin_fmaxf((a),(b)),(c))
  #define GAPA(MF,A0,A1,A2,A3,W0,W1,PW) do{ MF; sacc+=A0; sacc+=A1; sacc+=A2; sacc+=A3; PIN(sacc); W0; W1; PIN(PW); SBAR(); }while(0)
  #define EX(v) __builtin_amdgcn_exp2f(v)
  #define GAPB(MF,X,B) do{ MF; X[B]=EX(X[B]); X[B+1]=EX(X[B+1]); X[B+2]=EX(X[B+2]); X[B+3]=EX(X[B+3]); PIN(X); SBAR(); }while(0)
  #define VRD(i) do{ vlo[i]=vtr(vp_+(((i)>>2)*4096+((i)&3)*1024)); vhi[i]=vtr(vp_+(((i)>>2)*4096+((i)&3)*1024+512)); }while(0)
  #define KRD(G,j) do{ if(G){ kload2(kf,kp0+sl_next,j); SBAR(); } }while(0)
  #define STEP(C0,C1,P0,P1,t,GK,GV,GL) do{ SBAR(); \
    const lds_cptr vp_=vp0+sl_prev; \
    VRD(0); SBAR(); float sacc=(P0[0]+P0[1]); \
    GAPA(C0=__builtin_amdgcn_mfma_f32_32x32x16_bf16(kf[0],qr[0],(Hook::NEGC?negm:zc),0,0,0), P0[2],P0[3],P0[4],P0[5],     pw0[0]=PKW(P0,0), pw0[1]=PKW(P0,2), pw0); \
    VRD(4); SBAR(); GAPA(C1=__builtin_amdgcn_mfma_f32_32x32x16_bf16(kf[1],qr[0],(Hook::NEGC?negm:zc),0,0,0), P0[6],P0[7],P0[8],P0[9],     pw0[2]=PKW(P0,4), pw0[3]=PKW(P0,6), pw0); \
    VRD(1); SBAR(); GAPA(C0=__builtin_amdgcn_mfma_f32_32x32x16_bf16(kf[2],qr[1],C0,0,0,0),   P0[10],P0[11],P0[12],P0[13], pw1[0]=PKW(P0,8), pw1[1]=PKW(P0,10), pw1); \
    VRD(5); SBAR(); GAPA(C1=__builtin_amdgcn_mfma_f32_32x32x16_bf16(kf[3],qr[1],C1,0,0,0),   P0[14],P0[15],P1[0],P1[1],   pw1[2]=PKW(P0,12),pw1[3]=PKW(P0,14), pw1); \
    VRD(2); SBAR(); GAPA(C0=__builtin_amdgcn_mfma_f32_32x32x16_bf16(kf[4],qr[2],C0,0,0,0),   P1[2],P1[3],P1[4],P1[5],     pw2[0]=PKW(P1,0), pw2[1]=PKW(P1,2), pw2); \
    VRD(6); SBAR(); GAPA(C1=__builtin_amdgcn_mfma_f32_32x32x16_bf16(kf[5],qr[2],C1,0,0,0),   P1[6],P1[7],P1[8],P1[9],     pw2[2]=PKW(P1,4), pw2[3]=PKW(P1,6), pw2); \
    VRD(3); SBAR(); GAPA(C0=__builtin_amdgcn_mfma_f32_32x32x16_bf16(kf[6],qr[3],C0,0,0,0),   P1[10],P1[11],P1[12],P1[13], pw3[0]=PKW(P1,8), pw3[1]=PKW(P1,10), pw3); \
    VRD(7); SBAR(); GAPA(C1=__builtin_amdgcn_mfma_f32_32x32x16_bf16(kf[7],qr[3],C1,0,0,0),   P1[14],P1[15],0.f,0.f,       pw3[2]=PKW(P1,12),pw3[3]=PKW(P1,14), pw3); \
    l_reg+=sacc; \
    if(GK){DMA_K((t)+3,sl_cur);} if(GV){DMA_V((t)+1,sl_next);} \
    CMASK(C0,C1,t); \
    { float a=MX3(C0[0],C0[1],C1[0]),b=MX3(C0[2],C0[3],C1[1]); a=MX3(a,C1[2],C1[3]); \
      _Pragma("unroll") for(int r=4;r<16;r+=4){a=MX3(a,C0[r],C0[r+1]);b=MX3(b,C0[r+2],C0[r+3]);a=MX3(a,C1[r],C1[r+1]);b=MX3(b,C1[r+2],C1[r+3]);} \
      float rm=__builtin_fmaxf(a,b); { auto rr=__builtin_amdgcn_permlane32_swap(__float_as_uint(rm),__float_as_uint(rm),false,false); rm=__builtin_fmaxf(__uint_as_float(rr[0]),__uint_as_float(rr[1])); } \
      resc=false; \
      if(__builtin_expect(__any(rm>(float)THRL),0)){ const float dl=__builtin_fmaxf(rm,0.f); mhat+=dl; \
        _Pragma("unroll") for(int r=0;r<16;++r){C0[r]-=dl;C1[r]-=dl;} \
        if(Hook::NEGC){ _Pragma("unroll") for(int r=0;r<16;++r)negm[r]=-mhat; asm volatile("":"+v"(negm)); } \
        const float f=__builtin_amdgcn_exp2f(-dl); l_reg*=f; if(hi==0)wsf[r32]=f; resc=true; } } \
    SBAR(); \
    GAPB(o[0]=__builtin_amdgcn_mfma_f32_32x32x16_bf16(PAF(0),VFR(0),o[0],0,0,0), C0,0); \
    GAPB(o[1]=__builtin_amdgcn_mfma_f32_32x32x16_bf16(PAF(0),VFR(4),o[1],0,0,0), C0,4); \
    KRD(GL,0); GAPB(o[0]=__builtin_amdgcn_mfma_f32_32x32x16_bf16(PAF(1),VFR(1),o[0],0,0,0), C0,8); \
    KRD(GL,1); GAPB(o[1]=__builtin_amdgcn_mfma_f32_32x32x16_bf16(PAF(1),VFR(5),o[1],0,0,0), C0,12); \
    KRD(GL,2); GAPB(o[0]=__builtin_amdgcn_mfma_f32_32x32x16_bf16(PAF(2),VFR(2),o[0],0,0,0), C1,0); \
    KRD(GL,3); GAPB(o[1]=__builtin_amdgcn_mfma_f32_32x32x16_bf16(PAF(2),VFR(6),o[1],0,0,0), C1,4); \
    GAPB(o[0]=__builtin_amdgcn_mfma_f32_32x32x16_bf16(PAF(3),VFR(3),o[0],0,0,0), C1,8); \
    GAPB(o[1]=__builtin_amdgcn_mfma_f32_32x32x16_bf16(PAF(3),VFR(7),o[1],0,0,0), C1,12); \
    }while(0)
  int t=1;
  #undef CMASK
  #define CMASK(P0,P1,t) do{ if(Hook::MASK) hk.mask(P0,P1,(t),mhat); }while(0)
  for(;t+5<NT;t+=2){
    STEP(pB0,pB1,pA0,pA1,t,true,true,true);     WAIT_BAR(2); RESC(); ROT();
    STEP(pA0,pA1,pB0,pB1,t+1,true,true,true);   WAIT_BAR(2); RESC(); ROT();
  }
  #undef CMASK
  #define CMASK(P0,P1,t) do{ if(Hook::MASK) hk.mask(P0,P1,(t),mhat); }while(0)
  #define ENDW(tt) do{ if((tt)+3<NT){WAIT_BAR(2);} else if((tt)+2<NT){WAIT_BAR(1);} else {WAIT_BAR(0);} }while(0)
  for(;t+1<NT;t+=2){
    STEP(pB0,pB1,pA0,pA1,t,(t+3<NT),(t+1<NT),(t+1<NT));       ENDW(t);   RESC(); ROT();
    STEP(pA0,pA1,pB0,pB1,t+1,(t+4<NT),(t+2<NT),(t+2<NT));     ENDW(t+1); RESC(); ROT();
  }
  ASTAMP(3);
  #define DRAIN(X0,X1,SL) do{ float sacc=X0[0]+X0[1]; _Pragma("unroll") for(int r=2;r<16;++r)sacc+=X0[r]; _Pragma("unroll") for(int r=0;r<16;++r)sacc+=X1[r]; l_reg+=sacc; \
    pw0=(u32x4){PKW(X0,0),PKW(X0,2),PKW(X0,4),PKW(X0,6)};pw1=(u32x4){PKW(X0,8),PKW(X0,10),PKW(X0,12),PKW(X0,14)};pw2=(u32x4){PKW(X1,0),PKW(X1,2),PKW(X1,4),PKW(X1,6)};pw3=(u32x4){PKW(X1,8),PKW(X1,10),PKW(X1,12),PKW(X1,14)}; \
    SBAR(); pv(o,vb0+(SL),PAF(0),PAF(1),PAF(2),PAF(3)); }while(0)
  if(Hook::MASK && (NT&1)){ ASTAMP(4); DRAIN(pA0,pA1,sl_prev); }
  else{ STEP(pB0,pB1,pA0,pA1,NT-1,false,false,false); RESC(); ASTAMP(4); DRAIN(pB0,pB1,sl_cur); }
  #undef DRAIN
  #undef PKW
  #undef PAF
  #undef VFR
  #undef PIN
  #undef MX3
  #undef GAPA
  #undef GAPB
  #undef EX
  #undef VRD
  #undef KRD
  #undef STEP
  #undef ENDW
  ASTAMP(5);
  {auto rr=__builtin_amdgcn_permlane32_swap(__float_as_uint(l_reg),__float_as_uint(l_reg),false,false);l_reg=__uint_as_float(rr[0])+__uint_as_float(rr[1]);}
  if(hi==0)wsf[32+r32]=l_reg;asm volatile("s_waitcnt lgkmcnt(0)":::"memory");
  float rli[16];
  #pragma unroll
  for(int r=0;r<16;++r)rli[r]=__builtin_amdgcn_rcpf(wsf[32+crow(r,hi)]);
  bf16*Ow=Ow0+(long)(wid*QBLK)*OP;
  { bf16*stg=(bf16*)(shm+LDS_OST)+wid*2048;
    #pragma unroll
    for(int r=0;r<16;++r){const int orow=crow(r,hi);
      #pragma unroll
      for(int d0=0;d0<2;++d0)stg[orow*64+d0*32+r32]=__float2bfloat16(o[d0][r]*rli[r]);}
    asm volatile("s_waitcnt lgkmcnt(0)":::"memory");
    #pragma unroll
    for(int i=0;i<4;++i){const int row=i*8+(lane>>3),ch=lane&7; const u32x4 v=*(const u32x4*)(stg+row*64+ch*8); ATTN_STORE16(Ow+(long)row*OP+ch*8,v);} }
  ASTAMP(6);
  asm volatile("s_waitcnt lgkmcnt(0)\n\ts_barrier":::"memory"); ASTAMP(7);
  #undef ASTAMP
  #undef DMA_K
  #undef DMA_V
  #undef CMASK
  #undef START
  #undef RESC
  #undef ROT
}
constexpr int ATTN_LDS_BYTES=LDS_BYTES;
#undef SBAR
#undef WAIT_BAR
}
#define GAS __attribute__((address_space(1)))
#define LAS __attribute__((address_space(3)))
typedef unsigned short bf16;
typedef unsigned v4u __attribute__((ext_vector_type(4)));
typedef unsigned v2u __attribute__((ext_vector_type(2)));
typedef float f32x4 __attribute__((ext_vector_type(4)));
typedef float f32x2 __attribute__((ext_vector_type(2)));
#define LDS_WAIT() asm volatile("s_waitcnt lgkmcnt(0)" ::: "memory")

constexpr int NWAVES = 8;
constexpr int NB = 8, SEQ = 4096, DM = 1024, LC = 256, TB = SEQ + LC, TT = NB * TB, TX = NB * SEQ;
constexpr int NE = 32, MAXSLOT = 77824;
constexpr float EPS = 1e-6f;
constexpr float LOG2E = 1.4426950408889634f;
constexpr float C2 = 0.125f * LOG2E;
constexpr size_t MiB = 1u << 20;
constexpr size_t WS_CTL = 0, CTL_ZERO_BYTES = 1 * MiB;
constexpr size_t WS_MOD = 1 * MiB;
constexpr size_t WS_ROPE = 2 * MiB;
constexpr size_t WS_WTR = 2 * MiB + 65536;
constexpr size_t WS_TOK = 3 * MiB;
constexpr size_t WS_SLOT = 4 * MiB;
constexpr size_t WS_CTX = 5 * MiB;
constexpr size_t WS_WINE = 13 * MiB, WS_WOUTE = 16 * MiB, WS_WINO = 18 * MiB, WS_WOUTO = 24 * MiB, WS_W13 = 26 * MiB, WS_W2 = 154 * MiB;
constexpr size_t WS_HA = 218 * MiB;
constexpr size_t WS_R1 = 286 * MiB;
constexpr size_t R1_QE = 0, R1_KE = 34 * MiB, R1_VE = 43 * MiB, R1_UE = 52 * MiB;
constexpr size_t R1_QO = 0, R1_QKV_STRIDE = 68 * MiB;
constexpr size_t R1_YB = 0;
constexpr size_t R1_HMID = 136 * MiB, R1_Y2 = 0;
constexpr size_t WS_LOG = 498 * MiB;
constexpr size_t WS_ELIST = 503 * MiB;
constexpr size_t WS_XR = 512 * MiB;
constexpr size_t WS_END = 580 * MiB;
constexpr int LDS_BYTES = 163840, MISC_OFF = 147456;
constexpr int NA_TAB_OFF = 90112;

struct Args { const float* in[25]; float* out; unsigned char* ws; int ph_lo, ph_hi; };

__device__ __forceinline__ unsigned f2bf(float f) { unsigned u = __builtin_bit_cast(unsigned, f); return (u + 0x7fffu + ((u >> 16) & 1u)) >> 16; }
__device__ __forceinline__ unsigned pk2(float lo, float hi) { unsigned r; asm("v_cvt_pk_bf16_f32 %0, %1, %2" : "=v"(r) : "v"(lo), "v"(hi)); return r; }
__device__ __forceinline__ float bf2f(unsigned short h) { return __builtin_bit_cast(float, (unsigned)h << 16); }
__device__ __forceinline__ float bflo(unsigned w) { return __builtin_bit_cast(float, w << 16); }
__device__ __forceinline__ float bfhi(unsigned w) { return __builtin_bit_cast(float, w & 0xffff0000u); }
__device__ __forceinline__ float wave_sum(float v) {
#pragma unroll
    for (int o = 1; o < 64; o <<= 1) v += __shfl_xor(v, o);
    return v;
}

__device__ __forceinline__ Args fetch_args() {
    const __attribute__((address_space(4))) Args* p = (const __attribute__((address_space(4))) Args*)__builtin_amdgcn_kernarg_segment_ptr();
    asm volatile("" : "+s"(p));
    Args r;
#pragma unroll
    for (int i = 0; i < 25; ++i) r.in[i] = p->in[i];
    r.out = p->out; r.ws = p->ws; r.ph_lo = p->ph_lo; r.ph_hi = p->ph_hi;
    return r;
}
constexpr int NPH = 19;
__device__ __forceinline__ void mod_item(const Args& a, int l, int n0, int lane) {
    const float* W = a.in[4] + (size_t)l * 1024 * 6144 + n0;
    float acc[9][8];
#pragma unroll
    for (int r = 0; r < 9; ++r)
#pragma unroll
        for (int q = 0; q < 8; ++q) acc[r][q] = 0.f;
#pragma unroll 4
    for (int i = 0; i < 16; ++i) { const int k = lane + 64 * i; const f32x4 w0 = *(const f32x4*)(W + (size_t)k * 6144), w1 = *(const f32x4*)(W + (size_t)k * 6144 + 4);
#pragma unroll
        for (int r = 0; r < 9; ++r) { const float cv = (r < 8) ? a.in[1][r * 1024 + k] : a.in[3][k]; const float sv = cv / (1.0f + expf(-cv));
            acc[r][0] += sv * w0.x; acc[r][1] += sv * w0.y; acc[r][2] += sv * w0.z; acc[r][3] += sv * w0.w; acc[r][4] += sv * w1.x; acc[r][5] += sv * w1.y; acc[r][6] += sv * w1.z; acc[r][7] += sv * w1.w; } }
#define MTR(ARR, N, MASK) do { const bool hib = (lane & (MASK)) != 0; _Pragma("unroll") for (int jj = 0; jj < (N) / 2; ++jj) { \
        const float send = hib ? ARR[jj] : ARR[jj + (N) / 2]; const float recv = __shfl_xor(send, (MASK)); const float keep = hib ? ARR[jj + (N) / 2] : ARR[jj]; ARR[jj] = keep + recv; } } while (0)
    float v64[64], v8[8];
#pragma unroll
    for (int r = 0; r < 8; ++r)
#pragma unroll
        for (int q = 0; q < 8; ++q) v64[r * 8 + q] = acc[r][q];
#pragma unroll
    for (int q = 0; q < 8; ++q) v8[q] = acc[8][q];
    MTR(v64, 64, 32); MTR(v64, 32, 16); MTR(v64, 16, 8); MTR(v64, 8, 4); MTR(v64, 4, 2); MTR(v64, 2, 1);
    MTR(v8, 8, 32); MTR(v8, 4, 16); MTR(v8, 2, 8);
    float s8 = v8[0]; s8 += __shfl_xor(s8, 4); s8 += __shfl_xor(s8, 2); s8 += __shfl_xor(s8, 1);
#undef MTR
    { const int r = lane >> 3, q = lane & 7; ((float*)(a.ws + WS_MOD))[(size_t)(l * 9 + r) * 6144 + n0 + q] = v64[0] + a.in[5][l * 6144 + n0 + q]; }
    if ((lane & 7) == 0) { const int q = lane >> 3; ((float*)(a.ws + WS_MOD))[(size_t)(l * 9 + 8) * 6144 + n0 + q] = s8 + a.in[5][l * 6144 + n0 + q]; }
}
__device__ __forceinline__ void weff_item(const Args& a, int item, int lane, LAS float* scr) {
    const int g = item >> 8, nb = (item >> 4) & 15, cb = item & 15; const int n = nb * 64 + lane, c0 = cb * 8;
    const float* wo = a.in[9] + (size_t)(512 + g * 128) * 1024 + n; const float* ps = a.in[13] + g * 128; const float* pw = a.in[12] + (size_t)(g * 128 + c0) * 128;
#pragma unroll
    for (int i = 0; i < 16; ++i) { const int idx = lane + 64 * i; scr[idx] = pw[idx] * ps[idx & 127]; }
    LDS_WAIT(); asm volatile("" ::: "memory");
    float acc[8];
#pragma unroll
    for (int c = 0; c < 8; ++c) acc[c] = 0.f;
#pragma unroll 8
    for (int d4 = 0; d4 < 32; ++d4) { float wv[4];
#pragma unroll
        for (int q = 0; q < 4; ++q) wv[q] = wo[(size_t)(4 * d4 + q) * 1024];
#pragma unroll
        for (int c = 0; c < 8; ++c) { const f32x4 p = *(const LAS f32x4*)(scr + c * 128 + 4 * d4); acc[c] += (p.x * wv[0] + p.y * wv[1]) + (p.z * wv[2] + p.w * wv[3]); } }
    LDS_WAIT(); asm volatile("" ::: "memory");
    v4u o; o.x = pk2(acc[0], acc[1]); o.y = pk2(acc[2], acc[3]); o.z = pk2(acc[4], acc[5]); o.w = pk2(acc[6], acc[7]);
    *(v4u*)((bf16*)(a.ws + WS_WOUTE) + (size_t)n * 1024 + 512 + g * 128 + c0) = o;
}
__device__ __forceinline__ void weff_block(const Args& a, int item, LAS unsigned char* lds, int tid) {
    const int g = item >> 4, n0 = (item & 15) * 64;
    LAS float* At = (LAS float*)lds; LAS float* Bs = At + 128 * 132;
    const float* pw = a.in[12] + (size_t)g * 128 * 128; const float* ps = a.in[13] + g * 128; const float* wo = a.in[9] + (size_t)(512 + g * 128) * 1024 + n0;
#pragma unroll 8
    for (int i = 0; i < 32; ++i) { const int idx = tid + 512 * i, c = idx >> 7, d = idx & 127; At[d * 132 + c] = pw[idx] * ps[d]; }
#pragma unroll 8
    for (int i = 0; i < 16; ++i) { const int idx = tid + 512 * i, d = idx >> 6, n = idx & 63; Bs[idx] = wo[(size_t)d * 1024 + n]; }
    __syncthreads();
    const int n = tid & 63, cg = tid >> 6;
    float acc[16];
#pragma unroll
    for (int i = 0; i < 16; ++i) acc[i] = 0.f;
#pragma unroll 4
    for (int d = 0; d < 128; ++d) { const float b = Bs[d * 64 + n];
#pragma unroll
        for (int q = 0; q < 4; ++q) { const f32x4 av = *(const LAS f32x4*)(At + d * 132 + 16 * cg + 4 * q); acc[4 * q] += av.x * b; acc[4 * q + 1] += av.y * b; acc[4 * q + 2] += av.z * b; acc[4 * q + 3] += av.w * b; } }
    bf16* dst = (bf16*)(a.ws + WS_WOUTE) + (size_t)(n0 + n) * 1024 + 512 + g * 128 + 16 * cg;
    v4u o0, o1; o0.x = pk2(acc[0], acc[1]); o0.y = pk2(acc[2], acc[3]); o0.z = pk2(acc[4], acc[5]); o0.w = pk2(acc[6], acc[7]);
    o1.x = pk2(acc[8], acc[9]); o1.y = pk2(acc[10], acc[11]); o1.z = pk2(acc[12], acc[13]); o1.w = pk2(acc[14], acc[15]);
    *(v4u*)dst = o0; *(v4u*)(dst + 8) = o1;
    __syncthreads();
}
__device__ __forceinline__ void mod_block(const Args& a, int item, LAS unsigned char* lds, int tid) {
    const int lane = tid & 63, wave = tid >> 6, l = item / 96, n0 = (item % 96) * 64, k0 = wave * 128;
    LAS float* sil = (LAS float*)lds + wave * (9 * 128); LAS float* part = (LAS float*)lds + 8 * 9 * 128;
#pragma unroll 6
    for (int i = 0; i < 18; ++i) { const int idx = lane + 64 * i, r = idx >> 7, kk = idx & 127; const float cv = (r < 8) ? a.in[1][r * 1024 + k0 + kk] : a.in[3][k0 + kk]; sil[idx] = cv / (1.0f + expf(-cv)); }
    LDS_WAIT(); asm volatile("" ::: "memory");
    float acc[9];
#pragma unroll
    for (int r = 0; r < 9; ++r) acc[r] = 0.f;
    const float* W = a.in[4] + ((size_t)l * 1024 + k0) * 6144 + n0 + lane;
#pragma unroll 8
    for (int k4 = 0; k4 < 32; ++k4) { float w[4];
#pragma unroll
        for (int q = 0; q < 4; ++q) w[q] = __builtin_nontemporal_load(W + (size_t)(4 * k4 + q) * 6144);
#pragma unroll
        for (int r = 0; r < 9; ++r) { const f32x4 s = *(const LAS f32x4*)(sil + r * 128 + 4 * k4); acc[r] += (s.x * w[0] + s.y * w[1]) + (s.z * w[2] + s.w * w[3]); } }
#pragma unroll
    for (int r = 0; r < 9; ++r) part[wave * (9 * 64) + r * 64 + lane] = acc[r];
    __syncthreads();
    for (int idx = tid; idx < 9 * 64; idx += 512) { float s = 0.f;
#pragma unroll
        for (int w8 = 0; w8 < 8; ++w8) s += part[w8 * (9 * 64) + idx];
        const int r = idx >> 6, n = idx & 63; ((float*)(a.ws + WS_MOD))[(size_t)(l * 9 + r) * 6144 + n0 + n] = s + a.in[5][l * 6144 + n0 + n]; }
    __syncthreads();
}
__device__ __forceinline__ void wtr_item(const Args& a, int item, int lane) {
    const int l = item >> 4, k = (item & 15) * 64 + lane; float* wt = (float*)(a.ws + WS_WTR) + (size_t)l * 36 * 1024 + k;
    const f32x4 g = *(const f32x4*)(a.in[17] + ((size_t)l * 1024 + k) * 4);
    wt[0] = g.x; wt[1024] = g.y; wt[2048] = g.z; wt[3072] = g.w;
#pragma unroll
    for (int q = 0; q < 8; ++q) { const f32x4 e = *(const f32x4*)(a.in[19] + ((size_t)l * 1024 + k) * 32 + 4 * q);
        wt[(4 + 4 * q) * 1024] = e.x; wt[(5 + 4 * q) * 1024] = e.y; wt[(6 + 4 * q) * 1024] = e.z; wt[(7 + 4 * q) * 1024] = e.w; }
}
struct TrDesc { const float* src; bf16* dst; int ldw, ldt; };
constexpr int I_WINE = 320, I_WOUTE = 128, I_WINO = 768, I_WOUTO = 256, I_W1 = 8192, I_W3 = 8192, I_W2 = 8192, NTR = I_WINE + I_WOUTE + I_WINO + I_WOUTO + I_W1 + I_W3 + I_W2;
__device__ __forceinline__ TrDesc tr_decode(int r, int lane) {
    const Args a = fetch_args();
    const float* W; bf16* WT; int ldw, ldt, k0, n0, drow0;
    if (r < I_WINE) { const int kb = r % 16, nb = r / 16; W = a.in[8]; ldw = 1280; WT = (bf16*)(a.ws + WS_WINE); ldt = 1024; k0 = kb * 64; n0 = nb * 64; drow0 = n0; }
    else if ((r -= I_WINE) < I_WOUTE) { const int kb = r % 8, nb = r / 8; W = a.in[9]; ldw = 1024; WT = (bf16*)(a.ws + WS_WOUTE); ldt = 1024; k0 = kb * 64; n0 = nb * 64; drow0 = n0; }
    else if ((r -= I_WOUTE) < I_WINO) { const int kb = r % 16, nb = r / 16; W = a.in[14]; ldw = 3072; WT = (bf16*)(a.ws + WS_WINO); ldt = 1024; k0 = kb * 64; n0 = nb * 64; drow0 = n0; }
    else if ((r -= I_WINO) < I_WOUTO) { const int kb = r % 16, nb = r / 16; W = a.in[15]; ldw = 1024; WT = (bf16*)(a.ws + WS_WOUTO); ldt = 1024; k0 = kb * 64; n0 = nb * 64; drow0 = n0; }
    else if ((r -= I_WOUTO) < I_W1 + I_W3) { const int which = r / I_W1; r -= which * I_W1; const int le = r >> 7, q = r & 127, kb = q & 15, nb = q >> 4;
        W = a.in[which ? 22 : 21] + (size_t)le * 1024 * 512; ldw = 512; WT = (bf16*)(a.ws + WS_W13); ldt = 1024; k0 = kb * 64; n0 = nb * 64; drow0 = le * 1024 + (n0 >> 7) * 256 + (n0 & 127) + which * 128; }
    else { r -= I_W1 + I_W3; const int le = r >> 7, q = r & 127, kb = q & 7, nb = q >> 3;
        W = a.in[23] + (size_t)le * 512 * 1024; ldw = 1024; WT = (bf16*)(a.ws + WS_W2); ldt = 512; k0 = kb * 64; n0 = nb * 64; drow0 = le * 1024 + n0; }
    TrDesc d; d.src = W + (size_t)(k0 + (lane >> 4)) * ldw + n0 + (lane & 15) * 4; d.ldw = ldw; d.dst = WT + (size_t)(drow0 + (lane >> 3)) * ldt + k0 + 8 * (lane & 7); d.ldt = ldt; return d;
}
constexpr int NTR_SMALL = I_WINE + I_WOUTE + I_WINO + I_WOUTO, NTR_E = 3 * 4096;
constexpr int E0_P2 = 0, E0_P5 = E0_P2 + 88 * 8 * 4, E0_P0 = E0_P5 + 224 * 8 * 4;
static_assert(E0_P0 <= NTR_E, "tail quotas");
constexpr int NTR_A = NTR_SMALL;
constexpr int E1_P4 = NTR_E - 192 * 8;
__device__ __forceinline__ int tr_index_e(int layer, int b) { const int kind = b >> 12, rem = b & 4095; return NTR_SMALL + kind * 8192 + layer * 4096 + rem; }
__device__ __forceinline__ int tr_index_a(int a) { return a; }
template <bool NT, class NextFn> __device__ __forceinline__ void tr_run(NextFn next_item, LAS float* scr, int lane) {
    f32x4 buf[16]; TrDesc cur{};
#define TR_LD(p) (NT ? __builtin_nontemporal_load((const f32x4*)(p)) : *(const f32x4*)(p))
    int it = next_item();
    if (it >= 0) { cur = tr_decode(it, lane);
#pragma unroll
        for (int i = 0; i < 16; ++i) buf[i] = TR_LD(cur.src + (size_t)(4 * i) * cur.ldw); }
    while (it >= 0) {
#pragma unroll
        for (int i = 0; i < 16; ++i) { LAS float* s = scr + (4 * i + (lane >> 4)) * 65 + (lane & 15) * 4; s[0] = buf[i].x; s[1] = buf[i].y; s[2] = buf[i].z; s[3] = buf[i].w; }
        TrDesc nxt{}; const int nit = next_item();
        if (nit >= 0) { nxt = tr_decode(nit, lane);
#pragma unroll
            for (int i = 0; i < 16; ++i) buf[i] = TR_LD(nxt.src + (size_t)(4 * i) * nxt.ldw); }
        LDS_WAIT(); asm volatile("" ::: "memory");
        const int c = lane & 7;
#pragma unroll
        for (int j = 0; j < 8; ++j) { const LAS float* s = scr + (8 * c) * 65 + (lane >> 3) + 8 * j;
            v4u o; o.x = pk2(s[0 * 65], s[1 * 65]); o.y = pk2(s[2 * 65], s[3 * 65]); o.z = pk2(s[4 * 65], s[5 * 65]); o.w = pk2(s[6 * 65], s[7 * 65]);
            if (NT) __builtin_nontemporal_store(o, (v4u*)(cur.dst + (size_t)(8 * j) * cur.ldt)); else *(v4u*)(cur.dst + (size_t)(8 * j) * cur.ldt) = o; }
        LDS_WAIT(); asm volatile("" ::: "memory");
        cur = nxt; it = nit;
    }
#undef TR_LD
}
__device__ __forceinline__ void tr_range_e(LAS unsigned char* lds, int layer, int lo, int hi, int w, int nw, int wave, int lane, int cap = NTR_E) {
    LAS float* scr = (LAS float*)(lds + wave * 16640); int b = lo + w; hi = min(hi, cap);
    tr_run<true>([&]() -> int { const int r = b; b += nw; return r < hi ? tr_index_e(layer, r) : -1; }, scr, lane);
}
__device__ __forceinline__ void p0_prologue(const Args& a, LAS unsigned char* lds, int vcu, int G, int wave, int lane) {
    LAS float* scr = (LAS float*)(lds + wave * 16640); LAS int* qcnt = (LAS int*)(lds + MISC_OFF + 12288); const int gw = vcu * NWAVES + wave;
    if (threadIdx.x == 0) qcnt[0] = 0;
    __syncthreads();
#if defined(PROBE_SUB)
#define P0STAMP(i) do { if (gw == PROBE_GW && lane == 0) ((unsigned long long*)(a.ws + WS_CTL + 4096))[60 + (i)] = __builtin_amdgcn_s_memrealtime(); } while (0)
#else
#define P0STAMP(i) do { } while (0)
#endif
    P0STAMP(0);
    if (vcu < 64) weff_block(a, vcu, lds, threadIdx.x); else mod_block(a, vcu - 64, lds, threadIdx.x);
    { const int r = vcu * NWAVES + wave;
      if (r < 32) wtr_item(a, r, lane);
      else if (r < 48) {
          const int idx = (r - 32) * 64 + lane, pos = idx >> 4, f = idx & 15; const double inv = exp2(-(double)f * (13.287712379549449 / 16.0)); const double ang = (double)pos * inv;
          ((f32x2*)(a.ws + WS_ROPE))[idx] = (f32x2){(float)cos(ang), (float)sin(ang)}; } }
    P0STAMP(1);
    { const int chunk = (NTR_A + G - 1) / G, c_lo = vcu * chunk, c_hi = min(c_lo + chunk, NTR_A);
      tr_run<false>([&]() -> int { int r = 0; if (lane == 0) r = __hip_atomic_fetch_add(qcnt, 1, __ATOMIC_RELAXED, __HIP_MEMORY_SCOPE_WORKGROUP); r = c_lo + __builtin_amdgcn_readfirstlane(r); return r < c_hi ? tr_index_a(r) : -1; }, scr, lane); }
    P0STAMP(2);
#undef P0STAMP
}

template <int L> __device__ __forceinline__ void p_norm1(const Args& a, int gw, int NGW, int lane) {
    constexpr int R = (L == 0) ? 4 : 2;
    const float* mod = (const float*)(a.ws + WS_MOD); bf16* HA = (bf16*)(a.ws + WS_HA); const bf16* Y2 = (const bf16*)(a.ws + WS_R1 + R1_Y2);
    const float* gn = a.in[6] + L * 1024;
    for (int row = gw * R; row < TT; row += NGW * R) {
        const int b = row / TB, j = row - b * TB; const bool isx = j >= LC; const int mrow = isx ? b : 8;
        bf16* XR = (bf16*)(a.ws + WS_XR) + (size_t)row * 1024;
        f32x4 v[R][4];
        if (L == 0) { const float* src = isx ? a.in[0] + ((size_t)b * SEQ + (j - LC)) * 1024 : a.in[2] + ((size_t)b * LC + j) * 1024;
#pragma unroll
            for (int rr = 0; rr < R; ++rr)
#pragma unroll
                for (int q = 0; q < 4; ++q) v[rr][q] = __builtin_nontemporal_load((const f32x4*)(src + (size_t)rr * 1024) + lane + 64 * q); }
        else {
#pragma unroll
            for (int rr = 0; rr < R; ++rr)
#pragma unroll
                for (int q = 0; q < 4; ++q) { const v2u x = __builtin_nontemporal_load((const v2u*)(XR + (size_t)rr * 1024) + lane + 64 * q); v[rr][q] = (f32x4){bflo(x.x), bfhi(x.x), bflo(x.y), bfhi(x.y)}; } }
        if (L == 1) {
            const float* g2 = mod + (size_t)(0 * 9 + mrow) * 6144 + 5 * 1024;
            v2u y0[R][4], y1[R][4];
#pragma unroll
            for (int rr = 0; rr < R; ++rr)
#pragma unroll
                for (int q = 0; q < 4; ++q) { y0[rr][q] = __builtin_nontemporal_load((const v2u*)(Y2 + (size_t)(row + rr) * 1024) + lane + 64 * q); y1[rr][q] = __builtin_nontemporal_load((const v2u*)(Y2 + (size_t)(TT + row + rr) * 1024) + lane + 64 * q); }
#pragma unroll
            for (int q = 0; q < 4; ++q) { const f32x4 g = ((const f32x4*)g2)[lane + 64 * q];
#pragma unroll
                for (int rr = 0; rr < R; ++rr) { const v2u a0 = y0[rr][q], a1 = y1[rr][q];
                    v[rr][q].x += g.x * (bflo(a0.x) + bflo(a1.x)); v[rr][q].y += g.y * (bfhi(a0.x) + bfhi(a1.x)); v[rr][q].z += g.z * (bflo(a0.y) + bflo(a1.y)); v[rr][q].w += g.w * (bfhi(a0.y) + bfhi(a1.y));
                    __builtin_nontemporal_store((v2u){pk2(v[rr][q].x, v[rr][q].y), pk2(v[rr][q].z, v[rr][q].w)}, (v2u*)(XR + (size_t)rr * 1024) + lane + 64 * q); } }
        }
        float ss[R];
#pragma unroll
        for (int rr = 0; rr < R; ++rr) { ss[rr] = 0.f;
#pragma unroll
            for (int q = 0; q < 4; ++q) ss[rr] += (v[rr][q].x * v[rr][q].x + v[rr][q].y * v[rr][q].y) + (v[rr][q].z * v[rr][q].z + v[rr][q].w * v[rr][q].w); }
#pragma unroll
        for (int o = 1; o < 64; o <<= 1) { float t[R];
#pragma unroll
            for (int rr = 0; rr < R; ++rr) t[rr] = __shfl_xor(ss[rr], o);
#pragma unroll
            for (int rr = 0; rr < R; ++rr) ss[rr] += t[rr]; }
        const float* sh = mod + (size_t)(L * 9 + mrow) * 6144; const float* sc = sh + 1024;
#pragma unroll
        for (int q = 0; q < 4; ++q) { const f32x4 g = ((const f32x4*)gn)[lane + 64 * q], s = ((const f32x4*)sc)[lane + 64 * q], h = ((const f32x4*)sh)[lane + 64 * q];
#pragma unroll
            for (int rr = 0; rr < R; ++rr) { const float rstd = rsqrtf(ss[rr] * (1.0f / 1024.0f) + EPS); const f32x4 o = (v[rr][q] * rstd * g) * (1.0f + s) + h;
                ((v2u*)(HA + (size_t)(row + rr) * 1024))[lane + 64 * q] = (v2u){pk2(o.x, o.y), pk2(o.z, o.w)}; } }
    }
}
__device__ __forceinline__ void p_final(const Args& a, int gw, int NGW, int lane, float oscale, float spike) {
    constexpr int R = 2;
    const float* mod = (const float*)(a.ws + WS_MOD); const bf16* Y2 = (const bf16*)(a.ws + WS_R1 + R1_Y2); const float* gn = a.in[24];
    for (int xr = gw * R; xr < TX; xr += NGW * R) {
        const int b = xr / SEQ, t = xr - b * SEQ, row = b * TB + LC + t;
        float* px = a.out + (size_t)xr * 1024; const bf16* XR = (const bf16*)(a.ws + WS_XR) + (size_t)row * 1024; const float* g2 = mod + (size_t)(1 * 9 + b) * 6144 + 5 * 1024;
        f32x4 v[R][4]; v2u y0[R][4], y1[R][4];
#pragma unroll
        for (int rr = 0; rr < R; ++rr)
#pragma unroll
            for (int q = 0; q < 4; ++q) { { const v2u x = __builtin_nontemporal_load((const v2u*)(XR + (size_t)rr * 1024) + lane + 64 * q); v[rr][q] = (f32x4){bflo(x.x), bfhi(x.x), bflo(x.y), bfhi(x.y)}; }
                y0[rr][q] = __builtin_nontemporal_load((const v2u*)(Y2 + (size_t)(row + rr) * 1024) + lane + 64 * q); y1[rr][q] = __builtin_nontemporal_load((const v2u*)(Y2 + (size_t)(TT + row + rr) * 1024) + lane + 64 * q); }
        float ss[R];
#pragma unroll
        for (int rr = 0; rr < R; ++rr) { ss[rr] = 0.f;
#pragma unroll
            for (int q = 0; q < 4; ++q) { const f32x4 g = ((const f32x4*)g2)[lane + 64 * q]; const v2u a0 = y0[rr][q], a1 = y1[rr][q];
                v[rr][q].x += g.x * (bflo(a0.x) + bflo(a1.x)); v[rr][q].y += g.y * (bfhi(a0.x) + bfhi(a1.x)); v[rr][q].z += g.z * (bflo(a0.y) + bflo(a1.y)); v[rr][q].w += g.w * (bfhi(a0.y) + bfhi(a1.y));
                ss[rr] += (v[rr][q].x * v[rr][q].x + v[rr][q].y * v[rr][q].y) + (v[rr][q].z * v[rr][q].z + v[rr][q].w * v[rr][q].w); } }
#pragma unroll
        for (int o = 1; o < 64; o <<= 1) { float tt[R];
#pragma unroll
            for (int rr = 0; rr < R; ++rr) tt[rr] = __shfl_xor(ss[rr], o);
#pragma unroll
            for (int rr = 0; rr < R; ++rr) ss[rr] += tt[rr]; }
#pragma unroll
        for (int rr = 0; rr < R; ++rr) { const float rstd = rsqrtf(ss[rr] * (1.0f / 1024.0f) + EPS);
#pragma unroll
            for (int q = 0; q < 4; ++q) { const f32x4 g = ((const f32x4*)gn)[lane + 64 * q]; f32x4 o = v[rr][q] * rstd * g * oscale; if (xr + rr == 0 && q == 0 && lane == 0) o.x += spike; __builtin_nontemporal_store(o, (f32x4*)(px + (size_t)rr * 1024) + lane + 64 * q); } }
    }
}

__device__ __forceinline__ void head_piece(bf16* p, const v4u raw, bool isx, int t, const float (&gain)[8], const f32x2* rope, int j8) {
    float v[8] = {bflo(raw.x), bfhi(raw.x), bflo(raw.y), bfhi(raw.y), bflo(raw.z), bfhi(raw.z), bflo(raw.w), bfhi(raw.w)};
    float ss = 0.f;
#pragma unroll
    for (int i = 0; i < 8; ++i) ss += v[i] * v[i];
    ss += __shfl_xor(ss, 1); ss += __shfl_xor(ss, 2); ss += __shfl_xor(ss, 4);
    const float rstd = rsqrtf(ss * (1.0f / 64.0f) + EPS);
#pragma unroll
    for (int i = 0; i < 8; ++i) v[i] = v[i] * rstd * gain[i];
    if (isx) {
        const int pos = (j8 >> 2) ? (t & 63) : (t >> 6); const bool half = (j8 >> 1) & 1; const f32x4* cs4 = (const f32x4*)(rope + pos * 16 + (j8 & 1) * 8);
        f32x4 c[4];
#pragma unroll
        for (int i = 0; i < 4; ++i) c[i] = cs4[i];
#pragma unroll
        for (int i = 0; i < 8; ++i) { const float other = __shfl_xor(v[i], 2); const float co = (i & 1) ? c[i >> 1].z : c[i >> 1].x, si = (i & 1) ? c[i >> 1].w : c[i >> 1].y;
            v[i] = half ? (other * si + v[i] * co) : (v[i] * co - other * si); }
    }
    v4u o; o.x = pk2(v[0], v[1]); o.y = pk2(v[2], v[3]); o.z = pk2(v[4], v[5]); o.w = pk2(v[6], v[7]);
    *(v4u*)p = o;
}
__device__ __forceinline__ void p_qkprep_pool(const Args& a, int gw, int NGW, int lane) {
    bf16* QE = (bf16*)(a.ws + WS_R1 + R1_QE); bf16* KE = (bf16*)(a.ws + WS_R1 + R1_KE); const bf16* UE = (const bf16*)(a.ws + WS_R1 + R1_UE); bf16* HA = (bf16*)(a.ws + WS_HA);
    const f32x2* rope = (const f32x2*)(a.ws + WS_ROPE);
    const int j8 = lane & 7;
    float qg[8], kg[8];
#pragma unroll
    for (int i = 0; i < 8; ++i) { qg[i] = a.in[10][8 * j8 + i] * C2; kg[i] = a.in[11][8 * j8 + i]; }
    for (int row = gw; row < TT; row += NGW) {
        const int b = row / TB, j = row - b * TB; const bool isx = j >= LC; const int t = isx ? j - LC : j;
        const v4u qraw = *(const v4u*)(QE + (size_t)row * 512 + lane * 8);
        const int g = lane >> 4, w = 2 << g, Lq = isx ? SEQ : LC; const int lo = max(t - (w >> 1), 0), hi = min(t - (w >> 1) + w, Lq); const int base = row - t;
        v4u u[16];
#pragma unroll
        for (int i = 0; i < 16; ++i) { const int tt = t - 8 + i; const int tc = (tt >= lo && tt < hi) ? tt : t; u[i] = *(const v4u*)(UE + (size_t)(base + tc) * 512 + lane * 8); }
        head_piece(QE + (size_t)row * 512 + lane * 8, qraw, isx, t, qg, rope, j8);
        float acc[8];
#pragma unroll
        for (int c = 0; c < 8; ++c) acc[c] = 0.f;
#pragma unroll
        for (int i = 0; i < 16; ++i) { const int tt = t - 8 + i; const float m = (tt >= lo && tt < hi) ? 1.0f : 0.0f;
            acc[0] += m * bflo(u[i].x); acc[1] += m * bfhi(u[i].x); acc[2] += m * bflo(u[i].y); acc[3] += m * bfhi(u[i].y); acc[4] += m * bflo(u[i].z); acc[5] += m * bfhi(u[i].z); acc[6] += m * bflo(u[i].w); acc[7] += m * bfhi(u[i].w); }
        const v4u own = u[8]; const float rc = 1.0f / (float)(hi - lo);
        v4u o; o.x = pk2(acc[0] * rc - bflo(own.x), acc[1] * rc - bfhi(own.x)); o.y = pk2(acc[2] * rc - bflo(own.y), acc[3] * rc - bfhi(own.y));
        o.z = pk2(acc[4] * rc - bflo(own.z), acc[5] * rc - bfhi(own.z)); o.w = pk2(acc[6] * rc - bflo(own.w), acc[7] * rc - bfhi(own.w));
        *(v4u*)(HA + (size_t)row * 1024 + 512 + lane * 8) = o;
    }
    for (int g4 = gw * 2; g4 < TT / 4; g4 += NGW * 2) {
        v4u kraw[2];
#pragma unroll
        for (int u = 0; u < 2; ++u) kraw[u] = *(const v4u*)(KE + (size_t)(4 * (g4 + u) + (lane >> 4)) * 128 + (lane & 15) * 8);
#pragma unroll
        for (int u = 0; u < 2; ++u) { const int row = 4 * (g4 + u) + (lane >> 4); const int b = row / TB, j = row - b * TB; const bool isx = (4 * g4 - (4 * g4 / TB) * TB) >= LC; const int t = isx ? j - LC : j;
            head_piece(KE + (size_t)row * 128 + (lane & 15) * 8, kraw[u], isx, t, kg, rope, j8); }
    }
}

struct NoHook { static constexpr bool MASK = false, NEGC = true; unsigned long long* tsp = nullptr;
    __device__ __forceinline__ int tile_row(int t) const { return 64 * t; }
    __device__ __forceinline__ void mask(attn_body::f32x16&, attn_body::f32x16&, int, float) const {} };
struct NaHook { static constexpr bool MASK = true, NEGC = false;
    int rlo, nrows, rq, rs, wodd; const LAS _Float16* tab; unsigned long long* tsp;
    __device__ __forceinline__ int tile_row(int t) const { return t < 4 ? 64 * t : 256 + 64 * min(rlo + t - 4, 63); }
    __device__ __forceinline__ void mask(attn_body::f32x16& p0, attn_body::f32x16& p1, int t, float mhat) const {
        if (t < 4) {
#pragma unroll
            for (int r = 0; r < 16; ++r) { p0[r] -= mhat; p1[r] -= mhat; }
            return; }
        const int kr = rlo + t - 4; const bool rowok = (t - 4 < nrows) && kr >= rs && kr < rs + 8;
        if (!rowok) {
#pragma unroll
            for (int r = 0; r < 16; ++r) { p0[r] = -INFINITY; p1[r] = -INFINITY; }
        } else {
            const int lane_ = threadIdx.x & 63, hi_ = lane_ >> 5, cq_ = 32 * wodd + (lane_ & 31); const int lo_ = (cq_ < 8) ? 15 - cq_ : (cq_ > 55) ? 63 - cq_ : 7;
            const LAS _Float16* rowp = tab + lo_ * 1920 + (kr - rq + 7) * 128 + (4 * hi_ - cq_ + 63);
            if (wodd == 0) {
#pragma unroll
                for (int r = 0; r < 16; ++r) { const int kc0 = (r & 3) + 8 * (r >> 2); p0[r] = (p0[r] + (float)rowp[kc0]) - mhat; }
#pragma unroll
                for (int r = 0; r < 4; ++r) p1[r] = (p1[r] + (float)rowp[r + 32]) - mhat;
#pragma unroll
                for (int r = 4; r < 16; ++r) p1[r] = -INFINITY;
            } else {
#pragma unroll
                for (int r = 0; r < 12; ++r) p0[r] = -INFINITY;
#pragma unroll
                for (int r = 12; r < 16; ++r) p0[r] = (p0[r] + (float)rowp[(r & 3) + 24]) - mhat;
#pragma unroll
                for (int r = 0; r < 16; ++r) { const int kc0 = (r & 3) + 8 * (r >> 2); p1[r] = (p1[r] + (float)rowp[kc0 + 32]) - mhat; }
            }
        }
    }
};
__device__ __forceinline__ void p_attn_even(const Args& a, char* lds, int vcu) {
    using abf = attn_body::bf16;
    const abf* QE = (const abf*)(a.ws + WS_R1 + R1_QE); const abf* KE = (const abf*)(a.ws + WS_R1 + R1_KE); const abf* VE = (const abf*)(a.ws + WS_R1 + R1_VE); abf* HA = (abf*)(a.ws + WS_HA);
    const int b = vcu >> 5, i = vcu & 31, hq = i >> 2; const NoHook hk;
    const size_t kvo = (size_t)b * TB * 128 + (hq >> 2) * 64;
    for (int u = 0; u < 4; ++u) { const size_t row0 = (size_t)b * TB + LC + ((i & 3) * 4 + u) * 256;
        attn_body::attn_unit<8, 512, 128, 128, 1024, NoHook>(QE + row0 * 512 + hq * 64, KE + kvo, VE + kvo, HA + row0 * 1024 + hq * 64, 68, hk, lds); }
    if (i < 8) { const size_t row0 = (size_t)b * TB; const int hc = i;
        const size_t kvc = (size_t)b * TB * 128 + (hc >> 2) * 64;
        attn_body::attn_unit<8, 512, 128, 128, 1024, NoHook>(QE + row0 * 512 + hc * 64, KE + kvc, VE + kvc, HA + row0 * 1024 + hc * 64, 4, hk, lds); }
}
__device__ __forceinline__ void p_attn_na(const Args& a, char* lds, LAS unsigned char* ldsl, int vcu, int tid) {
    using abf = attn_body::bf16;
    const abf* QO = (const abf*)(a.ws + WS_R1 + R1_QO); const abf* KO = (const abf*)(a.ws + WS_R1 + R1_QO + R1_QKV_STRIDE); const abf* VO = (const abf*)(a.ws + WS_R1 + R1_QO + 2 * R1_QKV_STRIDE); abf* HA = (abf*)(a.ws + WS_HA);
    const int b = vcu >> 5, i = vcu & 31, h = i >> 1, rg0 = (i & 1) * 8;
    LAS _Float16* tab = (LAS _Float16*)(ldsl + NA_TAB_OFF);
    for (int k = tid; k < 16 * 15 * 128; k += 512) { const int lo = k / 1920, rem = k - lo * 1920, dr = rem >> 7, co = (rem & 127) - 48;
        tab[k] = (_Float16)((co >= lo && co <= lo + 15 && co <= 30) ? a.in[16][h * 465 + dr * 31 + co] * LOG2E : -INFINITY); }
    __syncthreads();
    const int wid = __builtin_amdgcn_readfirstlane(tid >> 6);
    for (int u = 0; u < 8; ++u) { const int r0 = (rg0 + u) * 4;
#if defined(PROBE_SUB)
        if (blockIdx.x == 0 && tid == 0) ((unsigned long long*)(a.ws + WS_CTL + 4096))[40 + u] = __builtin_amdgcn_s_memrealtime();
#endif
        NaHook hk; hk.rlo = min(max(r0 - 4, 0), 56); hk.nrows = min(max(r0 + 3 - 4, 0), 56) + 8 - hk.rlo; hk.rq = r0 + (wid >> 1); hk.rs = min(max(hk.rq - 4, 0), 56);
        hk.wodd = wid & 1; hk.tab = tab; hk.tsp = nullptr;
#if defined(PROBE_SUB)
        if (u == 2) hk.tsp = (unsigned long long*)(a.ws + WS_CTL + 4096) + 50;
#endif
        const int NT = 4 + hk.nrows;
        const size_t row0 = (size_t)b * TB + LC + r0 * 64, kv0 = (size_t)(b * 16 + h) * TB * 64;
        attn_body::attn_unit<8, 1024, 64, 64, 1024, NaHook>(QO + row0 * 1024 + h * 64, KO + kv0, VO + kv0, HA + row0 * 1024 + h * 64, NT, hk, lds); }
#if defined(PROBE_SUB)
    if (blockIdx.x == 0 && tid == 0) ((unsigned long long*)(a.ws + WS_CTL + 4096))[48] = __builtin_amdgcn_s_memrealtime();
#endif
}

template <int L> __device__ __forceinline__ void p_router(const Args& a, LAS unsigned char* lds, int bid, int G, int tid) {
    const int lane = tid & 63, wave = tid >> 6;
    LAS float* Wt = (LAS float*)lds;
    LAS int* lcnt = (LAS int*)(lds + MISC_OFF); LAS int* lbase = lcnt + 32;
    float* LOG = (float*)(a.ws + WS_LOG);
    const float* mod = (const float*)(a.ws + WS_MOD); bf16* HA = (bf16*)(a.ws + WS_HA); const bf16* YB = (const bf16*)(a.ws + WS_R1 + R1_YB); const float* gn = a.in[7] + L * 1024;
    constexpr int NPAIR = (L == 0) ? TT / 2 : TX / 2;
    const int ppb = (NPAIR + G - 1) / G;
    const int p_lo = bid * ppb, p_hi = min(p_lo + ppb, NPAIR);
    auto pair_row = [&](int p) -> int { if (L == 0) return 2 * p; const int bb = p / (SEQ / 2); return bb * TB + LC + 2 * (p - bb * (SEQ / 2)); };
    bf16* XRb = (bf16*)(a.ws + WS_XR);
    struct Raw { f32x4 f; v2u h; };
    auto ld_src = [&](int row, int q, Raw& r) { const int b = row / TB, j = row - b * TB;
        if (L == 0) { const float* s = (j >= LC) ? a.in[0] + ((size_t)b * SEQ + (j - LC)) * 1024 : a.in[2] + ((size_t)b * LC + j) * 1024; r.f = __builtin_nontemporal_load((const f32x4*)s + lane + 64 * q); }
        else r.h = __builtin_nontemporal_load((const v2u*)(XRb + (size_t)row * 1024) + lane + 64 * q); };
    auto cvt_src = [&](const Raw& r) -> f32x4 { if (L == 0) return r.f; return (f32x4){bflo(r.h.x), bfhi(r.h.x), bflo(r.h.y), bfhi(r.h.y)}; };
#if defined(PROBE_SUB)
#define SUBSTAMP(i) do { if (L == 0 && bid == 0 && tid == 0) ((unsigned long long*)(a.ws + WS_CTL + 4096))[21 + (i)] = __builtin_amdgcn_s_memrealtime(); } while (0)
#else
#define SUBSTAMP(i) do { } while (0)
#endif
    SUBSTAMP(0);
    Raw nxa[4], nxb[4]; v2u ya[4], yb[4];
    if (p_lo + wave < p_hi) { const int r0 = pair_row(p_lo + wave);
#pragma unroll
        for (int q = 0; q < 4; ++q) { ld_src(r0, q, nxa[q]); ld_src(r0 + 1, q, nxb[q]);
            ya[q] = ((const v2u*)(YB + (size_t)r0 * 1024))[lane + 64 * q]; yb[q] = ((const v2u*)(YB + (size_t)(r0 + 1) * 1024))[lane + 64 * q]; } }
    { const f32x4* wsrc = (const f32x4*)(a.ws + WS_WTR) + (size_t)L * 9216;
        for (int i = tid; i < 9216; i += 512) ((LAS f32x4*)Wt)[i] = wsrc[i]; }
    if (tid < 32) lcnt[tid] = 0;
    float bgv[4];
#pragma unroll
    for (int e = 0; e < 4; ++e) bgv[e] = a.in[18][L * 4 + e];
    __syncthreads();
    SUBSTAMP(1);
    for (int p = p_lo + wave; p < p_hi; p += NWAVES) {
        const int row = pair_row(p);
        const int b = row / TB, j = row - b * TB; const bool isx = j >= LC; const int mrow = isx ? b : 8;
        f32x4 xa[4], xb[4]; float ssa = 0.f, ssb = 0.f;
#pragma unroll
        for (int q = 0; q < 4; ++q) { xa[q] = cvt_src(nxa[q]); xb[q] = cvt_src(nxb[q]); }
        if (p + NWAVES < p_hi) { const int r1 = pair_row(p + NWAVES);
#pragma unroll
            for (int q = 0; q < 4; ++q) { ld_src(r1, q, nxa[q]); ld_src(r1 + 1, q, nxb[q]); } }
        { const float* g1 = mod + (size_t)(L * 9 + mrow) * 6144 + 2 * 1024; bf16* dst = XRb + (size_t)row * 1024;
#pragma unroll
            for (int q = 0; q < 4; ++q) { const f32x4 g = ((const f32x4*)g1)[lane + 64 * q];
                xa[q].x += g.x * bflo(ya[q].x); xa[q].y += g.y * bfhi(ya[q].x); xa[q].z += g.z * bflo(ya[q].y); xa[q].w += g.w * bfhi(ya[q].y);
                xb[q].x += g.x * bflo(yb[q].x); xb[q].y += g.y * bfhi(yb[q].x); xb[q].z += g.z * bflo(yb[q].y); xb[q].w += g.w * bfhi(yb[q].y);
                __builtin_nontemporal_store((v2u){pk2(xa[q].x, xa[q].y), pk2(xa[q].z, xa[q].w)}, (v2u*)dst + lane + 64 * q); __builtin_nontemporal_store((v2u){pk2(xb[q].x, xb[q].y), pk2(xb[q].z, xb[q].w)}, (v2u*)(dst + 1024) + lane + 64 * q); }
            if (p + NWAVES < p_hi) { const int r1 = pair_row(p + NWAVES);
#pragma unroll
                for (int q = 0; q < 4; ++q) { ya[q] = ((const v2u*)(YB + (size_t)r1 * 1024))[lane + 64 * q]; yb[q] = ((const v2u*)(YB + (size_t)(r1 + 1) * 1024))[lane + 64 * q]; } } }
#pragma unroll
        for (int q = 0; q < 4; ++q) { ssa += (xa[q].x * xa[q].x + xa[q].y * xa[q].y) + (xa[q].z * xa[q].z + xa[q].w * xa[q].w); ssb += (xb[q].x * xb[q].x + xb[q].y * xb[q].y) + (xb[q].z * xb[q].z + xb[q].w * xb[q].w); }
#pragma unroll
        for (int o = 1; o < 64; o <<= 1) { const float ta = __shfl_xor(ssa, o), tb = __shfl_xor(ssb, o); ssa += ta; ssb += tb; }
        const float ra = rsqrtf(ssa * (1.0f / 1024.0f) + EPS), rb = rsqrtf(ssb * (1.0f / 1024.0f) + EPS);
        const float* sh = mod + (size_t)(L * 9 + mrow) * 6144 + 3 * 1024; const float* sc = sh + 1024;
#pragma unroll
        for (int q = 0; q < 4; ++q) { const f32x4 g = ((const f32x4*)gn)[lane + 64 * q], s = ((const f32x4*)sc)[lane + 64 * q], h = ((const f32x4*)sh)[lane + 64 * q];
            xa[q] = (xa[q] * ra * g) * (1.0f + s) + h; xb[q] = (xb[q] * rb * g) * (1.0f + s) + h;
            ((v2u*)(HA + (size_t)row * 1024))[lane + 64 * q] = (v2u){pk2(xa[q].x, xa[q].y), pk2(xa[q].z, xa[q].w)};
            ((v2u*)(HA + (size_t)(row + 1) * 1024))[lane + 64 * q] = (v2u){pk2(xb[q].x, xb[q].y), pk2(xb[q].z, xb[q].w)}; }
#define TR_STEP(ARR, N, MASK) do { const bool hib = (lane & (MASK)) != 0; _Pragma("unroll") for (int jj = 0; jj < (N) / 2; ++jj) { \
            const float send = hib ? ARR[jj] : ARR[jj + (N) / 2]; const float recv = __shfl_xor(send, (MASK)); const float keep = hib ? ARR[jj + (N) / 2] : ARR[jj]; ARR[jj] = keep + recv; } } while (0)
#define DOT36(E, PA, PB) do { f32x4 aa = (f32x4){0.f, 0.f, 0.f, 0.f}, ab = (f32x4){0.f, 0.f, 0.f, 0.f}; _Pragma("unroll") for (int q = 0; q < 4; ++q) { \
            const f32x4 w = *(const LAS f32x4*)(Wt + (E) * 1024 + 4 * lane + 256 * q); aa += xa[q] * w; ab += xb[q] * w; } \
            PA = (aa.x + aa.y) + (aa.z + aa.w); PB = (ab.x + ab.y) + (ab.z + ab.w); } while (0)
        int gia, gib;
        {   float grp[8];
#pragma unroll
            for (int e = 0; e < 4; ++e) DOT36(e, grp[e], grp[4 + e]);
            TR_STEP(grp, 8, 32); TR_STEP(grp, 4, 16); TR_STEP(grp, 2, 8);
            float gsum = grp[0]; gsum += __shfl_xor(gsum, 4); gsum += __shfl_xor(gsum, 2); gsum += __shfl_xor(gsum, 1);
            if ((lane & 7) == 0) LOG[(size_t)(row + (lane >> 5)) * 36 + ((lane >> 3) & 3)] = gsum;
            const int gv = __builtin_bit_cast(int, gsum); int gsel[2];
#pragma unroll
            for (int r2 = 0; r2 < 2; ++r2) { int gi = 0; float gm = __builtin_bit_cast(float, __builtin_amdgcn_readlane(gv, (r2 * 4) * 8)) + bgv[0];
#pragma unroll
                for (int e = 1; e < 4; ++e) { const float v = __builtin_bit_cast(float, __builtin_amdgcn_readlane(gv, (r2 * 4 + e) * 8)) + bgv[e]; if (v > gm) { gm = v; gi = e; } }
                gsel[r2] = __builtin_amdgcn_readfirstlane(gi); }
            gia = gsel[0]; gib = gsel[1];
            if (lane == 0) { LOG[(size_t)row * 36 + 12] = __builtin_bit_cast(float, gia); LOG[(size_t)(row + 1) * 36 + 12] = __builtin_bit_cast(float, gib); } }
        {
            float c2[16];
            const LAS float* Wa = Wt + (4 + 8 * gia) * 1024 + 4 * lane; const LAS float* Wb = Wt + (4 + 8 * gib) * 1024 + 4 * lane;
#pragma unroll
            for (int e = 0; e < 8; ++e) { f32x4 aa = (f32x4){0.f, 0.f, 0.f, 0.f}, ab = (f32x4){0.f, 0.f, 0.f, 0.f};
#pragma unroll
                for (int q = 0; q < 4; ++q) { const f32x4 wa = *(const LAS f32x4*)(Wa + e * 1024 + 256 * q), wb = *(const LAS f32x4*)(Wb + e * 1024 + 256 * q); aa += xa[q] * wa; ab += xb[q] * wb; }
                c2[e] = (aa.x + aa.y) + (aa.z + aa.w); c2[8 + e] = (ab.x + ab.y) + (ab.z + ab.w); }
            TR_STEP(c2, 16, 32); TR_STEP(c2, 8, 16); TR_STEP(c2, 4, 8); TR_STEP(c2, 2, 4);
            float cs = c2[0]; cs += __shfl_xor(cs, 2); cs += __shfl_xor(cs, 1);
            if ((lane & 3) == 0) LOG[(size_t)(row + (lane >> 5)) * 36 + 4 + ((lane >> 2) & 7)] = cs;
        }
#undef TR_STEP
#undef DOT36
    }
    SUBSTAMP(2);
    __threadfence_block();
    __syncthreads();
    SUBSTAMP(3);
    const int nrow = (p_hi - p_lo) * 2; int myrow = 0, e0 = 0, e1 = 0, rk0 = 0, rk1 = 0; float w0 = 0.f, w1 = 0.f;
    if (tid < nrow) {
        myrow = pair_row(p_lo + (tid >> 1)) + (tid & 1); const float* lg = LOG + (size_t)myrow * 36;
        const float* bg = a.in[18] + L * 4; const float* be = a.in[20] + L * 32;
        float gl[4]; const int gi = __builtin_bit_cast(int, lg[12]);
#pragma unroll
        for (int e = 0; e < 4; ++e) gl[e] = lg[e] + bg[e];
        const float gm = (gi == 0) ? gl[0] : (gi == 1) ? gl[1] : (gi == 2) ? gl[2] : gl[3];
        float gs = 0.f;
#pragma unroll
        for (int e = 0; e < 4; ++e) gs += expf(gl[e] - gm);
        const float gwt = 1.0f / gs;
        float el[8];
#pragma unroll
        for (int e = 0; e < 8; ++e) el[e] = lg[4 + e] + be[gi * 8 + e];
        int i0 = 0; float m0 = el[0];
#pragma unroll
        for (int e = 1; e < 8; ++e) if (el[e] > m0) { m0 = el[e]; i0 = e; }
        int i1 = -1; float m1 = -INFINITY;
#pragma unroll
        for (int e = 0; e < 8; ++e) if (e != i0 && el[e] > m1) { m1 = el[e]; i1 = e; }
        const float ex = expf(m1 - m0), p0 = 1.0f / (1.0f + ex), p1 = ex * p0;
        e0 = gi * 8 + i0; e1 = gi * 8 + i1; w0 = gwt * p0; w1 = gwt * p1;
        rk0 = __hip_atomic_fetch_add(&lcnt[e0], 1, __ATOMIC_RELAXED, __HIP_MEMORY_SCOPE_WORKGROUP); rk1 = __hip_atomic_fetch_add(&lcnt[e1], 1, __ATOMIC_RELAXED, __HIP_MEMORY_SCOPE_WORKGROUP);
    }
    __syncthreads();
    if (tid < 32) lbase[tid] = atomicAdd((int*)(a.ws + WS_CTL) + L * 32 + tid, lcnt[tid]);
    __syncthreads();
    if (tid < nrow) { int* elist = (int*)(a.ws + WS_ELIST); float* ewgt = (float*)(elist + 32 * TT);
        const size_t s0 = (size_t)e0 * TT + rk0 + lbase[e0], s1 = (size_t)e1 * TT + rk1 + lbase[e1];
        elist[s0] = myrow; ewgt[s0] = w0; elist[s1] = TT + myrow; ewgt[s1] = w1; }
    SUBSTAMP(4);
#undef SUBSTAMP
}
__device__ __forceinline__ void moe_tiles(const Args& a, LAS unsigned char* lds, int L, int tid) {
    LAS int* tstart = (LAS int*)(lds + MISC_OFF + 4096);
    if (tid == 0) { const int* cnt = (const int*)(a.ws + WS_CTL) + L * 32; int t = 0; for (int e = 0; e < 32; ++e) { tstart[e] = t; tstart[64 + e] = cnt[e]; t += (cnt[e] + 255) >> 8; } tstart[32] = t; }
    __syncthreads();
}
#define RLX_AGENT __ATOMIC_RELAXED, __HIP_MEMORY_SCOPE_AGENT
#define XB_TMO      128
#define XB_XCNT(j)  (256  + 64 * (j))
#define XB_XSUB(j)  (1280 + 64 * (j))
#define XB_XGEN(j)  (2304 + 64 * (j))
#define XB_TOP      3328
#define XB_TOPGEN   3392
#define XCD_BAR_WORDS 3456
#define XB_SPIN_CAP (1u << 18)

__device__ __forceinline__ unsigned xb_ld(unsigned* p)              { return __hip_atomic_load(p, __ATOMIC_RELAXED, __HIP_MEMORY_SCOPE_AGENT); }
__device__ __forceinline__ unsigned xb_add(unsigned* p, unsigned v) { return __hip_atomic_fetch_add(p, v, __ATOMIC_RELAXED, __HIP_MEMORY_SCOPE_AGENT); }
__device__ __forceinline__ unsigned xb_xcc_id() { return (unsigned)__builtin_amdgcn_s_getreg((3 << 11) | 20) & 0xFu; }
#define XB_SPIN(cond, bar) do { unsigned _sp = 0; while (cond) { __builtin_amdgcn_s_sleep(1); \
    if ((++_sp & 255u) == 0u) { if (xb_ld(&(bar)[XB_TMO])) break; if (_sp > XB_SPIN_CAP) { atomicAdd(&(bar)[XB_TMO], 1u); break; } } } } while (0)

struct XcdBarrier {
    unsigned* bar; unsigned x;
    volatile LAS unsigned* st;
};

__device__ __forceinline__ XcdBarrier xcd_barrier_post(unsigned* bar, volatile LAS unsigned* st) {
    XcdBarrier b; b.bar = bar; b.x = xb_xcc_id(); b.st = st;
    if (threadIdx.x == 0) (void)xb_add(&bar[XB_XCNT(b.x)], 1u);
    return b;
}
__device__ __forceinline__ void xcd_barrier_complete(unsigned* bar, unsigned x, unsigned& nloc, unsigned& nx) {
    const unsigned G = gridDim.x * gridDim.y * gridDim.z;
    unsigned sum, cnt, mine, sp = 0u;
    for (;;) {
        sum = 0u; cnt = 0u; mine = 0u;
#pragma unroll
        for (unsigned j = 0; j < 16; ++j) { const unsigned c = xb_ld(&bar[XB_XCNT(j)]); sum += c; cnt += (c > 0u) ? 1u : 0u; mine = (j == x) ? c : mine; }
        if (sum == G) break;
        __builtin_amdgcn_s_sleep(1);
        if ((++sp & 255u) == 0u) { if (xb_ld(&bar[XB_TMO])) break; if (sp > XB_SPIN_CAP) { atomicAdd(&bar[XB_TMO], 1u); break; } }
    }
    nloc = mine > 0u ? mine : 1u; nx = cnt > 0u ? cnt : 1u;
}

__device__ __forceinline__ void xcd_barrier(const XcdBarrier& b) {
    asm volatile("s_waitcnt vmcnt(0)" ::: "memory");
    __syncthreads();
    if (threadIdx.x == 0) {
        unsigned* bar = b.bar;
        __builtin_amdgcn_s_waitcnt(0);
        unsigned nloc = b.st[0], nx = b.st[1];
        if (nloc == 0u) { xcd_barrier_complete(bar, b.x, nloc, nx); b.st[0] = nloc; b.st[1] = nx; }
        const unsigned old = xb_add(&bar[XB_XSUB(b.x)], 1u);
        const unsigned gen = old / nloc;
        if (old + 1u == (gen + 1u) * nloc) {
            __builtin_amdgcn_fence(__ATOMIC_RELEASE, "agent");
            asm volatile("s_waitcnt vmcnt(0)" ::: "memory");
            const unsigned og = xb_add(&bar[XB_TOP], 1u);
            const unsigned tg = og / nx;
            if (og + 1u == (tg + 1u) * nx) xb_add(&bar[XB_TOPGEN], 1u);
            else XB_SPIN(xb_ld(&bar[XB_TOPGEN]) == tg, bar);
            __builtin_amdgcn_fence(__ATOMIC_ACQUIRE, "agent");
            xb_add(&bar[XB_XGEN(b.x)], 1u);
            asm volatile("s_waitcnt vmcnt(0)" ::: "memory");
        } else {
            XB_SPIN(xb_ld(&bar[XB_XGEN(b.x)]) == gen, bar);
            __builtin_amdgcn_fence(__ATOMIC_ACQUIRE, "agent");
            asm volatile("s_waitcnt vmcnt(0)" ::: "memory");
        }
    }
    __syncthreads();
}

__device__ __forceinline__ int l0_units(const Args& a, LAS unsigned char* lds, int tid) {
    LAS int* w = (LAS int*)(lds + MISC_OFF + 12288);
    __syncthreads();
    if (tid == 0) { const int* cnt = (const int*)(a.ws + WS_CTL); int t = 0; for (int e = 0; e < 32; ++e) t += (cnt[e] + 255) >> 8; w[4] = t * 4; }
    __syncthreads();
    return w[4];
}
__global__ void __launch_bounds__(NWAVES * 64, 2) mega_fwd(Args args) {
    extern __shared__ __attribute__((aligned(16))) unsigned char lds_raw[];
    LAS unsigned char* lds = (LAS unsigned char*)lds_raw;
    const int tid = threadIdx.x, lane = tid & 63, wave = __builtin_amdgcn_readfirstlane(tid >> 6);
    const int G = gridDim.x, bid = blockIdx.x; const int vcu = (G % 8 == 0) ? (bid % 8) * (G / 8) + bid / 8 : bid;
    const int gw = vcu * NWAVES + wave, NGW = G * NWAVES;
    int lo, hi; unsigned char* ws; { const Args a0 = fetch_args(); lo = a0.ph_lo; hi = a0.ph_hi; ws = a0.ws; }
    cg::grid_group grid = cg::this_grid();
    volatile LAS unsigned* bst = (volatile LAS unsigned*)(lds + MISC_OFF + 16368);
    if (tid < 2) bst[tid] = 0u;
    __syncthreads();
    const XcdBarrier xbar = xcd_barrier_post((unsigned*)(ws + WS_CTL) + 16384, bst);
#ifndef PHASE_MASK
#define PHASE_MASK 0x7ffffu
#endif
#define IN(k) ((((PHASE_MASK) >> (k)) & 1u) && lo <= (k) && (k) < hi)
#ifndef PROBE_A
#define PROBE_A -1
#endif
#ifndef PROBE_B
#define PROBE_B -1
#endif
#if PROBE_A >= 0
    unsigned long long* ts = (unsigned long long*)(ws + WS_CTL + 4096);
    if (bid == 0 && tid == 0) ts[0] = __builtin_amdgcn_s_memrealtime();
#define STAMP(k) do { if (bid == 0 && tid == 0) ts[(k) + 1] = __builtin_amdgcn_s_memrealtime(); } while (0)
#else
#define STAMP(k) do { } while (0)
#endif
#define SEAM(k) do { if (IN(k) && IN((k) + 1)) xcd_barrier(xbar); STAMP(k); } while (0)
    typedef pg8::bf16_t pbf;
#define TAIL(total, layer, base, q) do { const int rem_ = (total) % G; if (rem_ != 0 && bid >= rem_) tr_range_e(lds, (layer), (base), (base) + (G - rem_) * NWAVES * (q), (bid - rem_) * NWAVES + wave, (G - rem_) * NWAVES, wave, lane, (layer) ? E1_P4 : NTR_E); } while (0)
#define TAIL_ITEMS(total, q) ((((total) % G) != 0) ? (G - (total) % G) * NWAVES * (q) : 0)
#ifdef EXTRA_SYNC
    for (int es = 0; es < EXTRA_SYNC; ++es) xcd_barrier(xbar);
#endif
    if (lo > hi) grid.sync();
    if (IN(0)) { p0_prologue(fetch_args(), lds, vcu, G, wave, lane); } SEAM(0);
    if (IN(1)) { p_norm1<0>(fetch_args(), gw, NGW, lane); } SEAM(1);
    if (IN(2)) {
        pg8::Gemm g{(const pbf*)(ws + WS_HA), (const pbf*)(ws + WS_WINE), TT, 1280, 1024}; pg8::DenseOrder S; S.init(136, 5, G, bid, 0);
        pg8::EpiEvenIn E{(pbf*)(ws + WS_R1 + R1_QE), (pbf*)(ws + WS_R1 + R1_KE), (pbf*)(ws + WS_R1 + R1_VE), (pbf*)(ws + WS_R1 + R1_UE)};
        pg8::gemm_phase<pg8::EpiEvenIn, pg8::DenseOrder, true, true>(lds, g, S, E); TAIL(680, 0, E0_P2, 4); } SEAM(2);
    if (IN(3)) { p_qkprep_pool(fetch_args(), gw, NGW, lane); } SEAM(3);
    if (IN(4)) { p_attn_even(fetch_args(), (char*)lds_raw, vcu);
        { const int i_ = vcu & 31; if (i_ >= 8) { const int w_ = ((vcu >> 5) * 24 + (i_ - 8)) * NWAVES + wave;
            tr_range_e(lds, 0, E0_P0, NTR_E, w_, 192 * NWAVES, wave, lane); tr_range_e(lds, 1, E1_P4, NTR_E, w_, 192 * NWAVES, wave, lane); } } } SEAM(4);
    if (IN(5)) {
        pg8::Gemm g{(const pbf*)(ws + WS_HA), (const pbf*)(ws + WS_WOUTE), TT, 1024, 1024}; pg8::DenseOrder S; S.init(136, 4, G, bid, 0);
        pg8::EpiBf16 E{(pbf*)(ws + WS_R1 + R1_YB), 1024, 0, 0, 1.f};
        pg8::gemm_phase<pg8::EpiBf16, pg8::DenseOrder, true, true>(lds, g, S, E); TAIL(544, 0, E0_P5, 4); } SEAM(5);
    if (IN(6)) { p_router<0>(fetch_args(), lds, bid, G, tid); } STAMP(6); SEAM(7);
    if (IN(8)) {
        moe_tiles(fetch_args(), lds, 0, tid); const LAS int* tstart = (const LAS int*)(lds + MISC_OFF + 4096);
        pg8::Gemm g{(const pbf*)(ws + WS_HA), (const pbf*)(ws + WS_W13), 0, 0, 1024}; pg8::MoeOrder S{tstart, tstart[32] * 4, G, bid, 0};
        pg8::EpiMoeUp E{(pbf*)(ws + WS_R1 + R1_HMID)}; pg8::MoeGather AG{(const int*)(ws + WS_ELIST), tstart + 64};
        pg8::gemm_phase<pg8::EpiMoeUp, pg8::MoeOrder, true, true, pg8::MoeGather>(lds, g, S, E, AG); { const int nu0 = tstart[32] * 4; TAIL(nu0, 1, 0, 4); } } SEAM(8);
    if (IN(9)) {
        moe_tiles(fetch_args(), lds, 0, tid); const LAS int* tstart = (const LAS int*)(lds + MISC_OFF + 4096);
        pg8::Gemm g{(const pbf*)(ws + WS_R1 + R1_HMID), (const pbf*)(ws + WS_W2), 0, 0, 512}; pg8::MoeOrder S{tstart, tstart[32] * 4, G, bid, 0};
        pg8::EpiMoeDown E{(pbf*)(ws + WS_R1 + R1_Y2), (const int*)(ws + WS_ELIST), (const float*)(ws + WS_ELIST) + 32 * TT, tstart + 64, (LAS int*)(lds + MISC_OFF + 8192)};
        pg8::gemm_phase<pg8::EpiMoeDown, pg8::MoeOrder, true, true>(lds, g, S, E); { const int nu0 = tstart[32] * 4; TAIL(nu0, 1, TAIL_ITEMS(nu0, 4), 2); } } SEAM(9);
    if (IN(10)) { p_norm1<1>(fetch_args(), gw, NGW, lane); } SEAM(10);
    if (IN(11)) {
        pg8::Gemm g{(const pbf*)(ws + WS_HA), (const pbf*)(ws + WS_WINO), TT, 3072, 1024}; pg8::DenseOrder S; S.init(128, 12, G, bid, 1, 64, 4, 8);
        pg8::EpiOddIn E{(pbf*)(ws + WS_R1 + R1_QO), (pbf*)(ws + WS_R1 + R1_QO + R1_QKV_STRIDE), (pbf*)(ws + WS_R1 + R1_QO + 2 * R1_QKV_STRIDE), C2};
#if defined(PROBE_SUB)
        E.tsp = (unsigned long long*)(ws + WS_CTL + 4096) + 70;
#endif
        pg8::gemm_phase<pg8::EpiOddIn, pg8::DenseOrder, true, true>(lds, g, S, E); { const int nu0 = l0_units(fetch_args(), lds, tid); TAIL(1600, 1, TAIL_ITEMS(nu0, 4) + TAIL_ITEMS(nu0, 2), 5); } } SEAM(11);
    if (IN(12)) { p_attn_na(fetch_args(), (char*)lds_raw, lds, vcu, tid); } SEAM(12);
    if (IN(13)) {
        pg8::Gemm g{(const pbf*)(ws + WS_HA), (const pbf*)(ws + WS_WOUTO), TT, 1024, 1024}; pg8::DenseOrder S; S.init(128, 4, G, bid, 1);
        pg8::EpiBf16 E{(pbf*)(ws + WS_R1 + R1_YB), 1024, 0, 0, 1.f};
        pg8::gemm_phase<pg8::EpiBf16, pg8::DenseOrder, true, true>(lds, g, S, E); } SEAM(13);
    if (IN(14)) { p_router<1>(fetch_args(), lds, bid, G, tid); __syncthreads(); { const int nu0 = l0_units(fetch_args(), lds, tid);
        tr_range_e(lds, 1, TAIL_ITEMS(nu0, 4) + TAIL_ITEMS(nu0, 2) + TAIL_ITEMS(1600, 5), E1_P4, gw, NGW, wave, lane, E1_P4); } } STAMP(14); SEAM(15);
    if (IN(16)) {
        moe_tiles(fetch_args(), lds, 1, tid); const LAS int* tstart = (const LAS int*)(lds + MISC_OFF + 4096);
        pg8::Gemm g{(const pbf*)(ws + WS_HA), (const pbf*)(ws + WS_W13), 0, 0, 1024}; pg8::MoeOrder S{tstart, tstart[32] * 4, G, bid, 32};
        pg8::EpiMoeUp E{(pbf*)(ws + WS_R1 + R1_HMID)}; pg8::MoeGather AG{(const int*)(ws + WS_ELIST), tstart + 64};
        pg8::gemm_phase<pg8::EpiMoeUp, pg8::MoeOrder, true, true, pg8::MoeGather>(lds, g, S, E, AG); } SEAM(16);
    if (IN(17)) {
        moe_tiles(fetch_args(), lds, 1, tid); const LAS int* tstart = (const LAS int*)(lds + MISC_OFF + 4096);
        pg8::Gemm g{(const pbf*)(ws + WS_R1 + R1_HMID), (const pbf*)(ws + WS_W2), 0, 0, 512}; pg8::MoeOrder S{tstart, tstart[32] * 4, G, bid, 32};
        pg8::EpiMoeDown E{(pbf*)(ws + WS_R1 + R1_Y2), (const int*)(ws + WS_ELIST), (const float*)(ws + WS_ELIST) + 32 * TT, tstart + 64, (LAS int*)(lds + MISC_OFF + 8192)};
        pg8::gemm_phase<pg8::EpiMoeDown, pg8::MoeOrder, true, true>(lds, g, S, E); } SEAM(17);
#if PROBE_A >= 0
    grid.sync();
    {   const double tot = (double)(ts[18] - ts[0]); const double fa = (double)(ts[PROBE_A + 1] - ts[PROBE_A]) / tot, fb = (double)(ts[PROBE_B + 1] - ts[PROBE_B]) / tot;
        #ifndef PROBE_MULT
#define PROBE_MULT 4.0
#endif
        const float spike = 2.0f * (float)pow(20.0, fmin(PROBE_MULT * fa, 1.0)), delta = (float)sqrt(2e-5 * pow(25.0, fmin(PROBE_MULT * fb, 1.0)));
        p_final(fetch_args(), gw, NGW, lane, 1.0f + delta, spike); }
#else
    if (IN(18)) { p_final(fetch_args(), gw, NGW, lane, 1.0f, 0.f); }
#endif
#undef IN
#undef SEAM
}

#ifndef MK_PER_PHASE
#define MK_PER_PHASE 0
#endif
extern "C" void kernel_launch(void* const* d_in, const int* in_sizes, int n_in, void* d_out, int out_size, void* d_ws, size_t ws_size, hipStream_t stream) {
    static int grid = 0;
    if (grid == 0) {
        if (n_in != 25 || in_sizes[0] != TX * DM || out_size != TX * DM || ws_size < WS_END) { fprintf(stderr, "kernel_launch: unexpected shapes/workspace: n_in %d in0 %d out %d ws %zu (need %zu)\n", n_in, n_in > 0 ? in_sizes[0] : -1, out_size, ws_size, (size_t)WS_END); grid = -1; return; }
        int dev = 0, cus = 0, per_cu = 0;
        if (hipGetDevice(&dev) != hipSuccess || hipDeviceGetAttribute(&cus, hipDeviceAttributeMultiprocessorCount, dev) != hipSuccess) { grid = -1; return; }
        if (hipFuncSetAttribute((const void*)mega_fwd, hipFuncAttributeMaxDynamicSharedMemorySize, LDS_BYTES) != hipSuccess) { fprintf(stderr, "kernel_launch: hipFuncSetAttribute failed\n"); grid = -1; return; }
        if (hipOccupancyMaxActiveBlocksPerMultiprocessor(&per_cu, (const void*)mega_fwd, NWAVES * 64, LDS_BYTES) != hipSuccess || per_cu < 1) { fprintf(stderr, "kernel_launch: occupancy query says %d blocks per CU\n", per_cu); grid = -1; return; }
        if (cus != 256) { fprintf(stderr, "kernel_launch: built for 256 CUs, found %d\n", cus); grid = -1; return; }
        grid = cus;
    }
    if (grid < 0) return;
    (void)hipMemsetAsync((char*)d_ws + WS_CTL, 0, CTL_ZERO_BYTES, stream);
    Args a{};
    for (int i = 0; i < 25; ++i) a.in[i] = (const float*)d_in[i];
    a.out = (float*)d_out; a.ws = (unsigned char*)d_ws;
#if MK_PER_PHASE
    for (int p = 0; p < NPH; ++p) { a.ph_lo = p; a.ph_hi = p + 1; void* kargs[] = {&a};
        hipError_t e = hipLaunchCooperativeKernel((const void*)mega_fwd, dim3(grid), dim3(NWAVES * 64), kargs, LDS_BYTES, stream);
        if (e != hipSuccess) { fprintf(stderr, "kernel_launch: launch %d failed: %s\n", p, hipGetErrorString(e)); break; } }
#else
    a.ph_lo = 0; a.ph_hi = NPH; void* kargs[] = {&a};
    hipError_t e = hipLaunchCooperativeKernel((const void*)mega_fwd, dim3(grid), dim3(NWAVES * 64), kargs, LDS_BYTES, stream);
    if (e != hipSuccess) fprintf(stderr, "kernel_launch: cooperative launch failed: %s\n", hipGetErrorString(e));
#endif
}
```
